# Optimizing an MI355X kernel written in HIP

```python
import math
import jax
import jax.numpy as jnp
from jax import lax
import numpy as np

D_MODEL = 1024
BATCH = 8
SEQ = 2048
DEPTH = 4
DEC_BATCH = 32
DEC_SEQ = 32
PAST_LEN = 2048

CHUNK = 64
W_A = D_MODEL // 4
W_B = D_MODEL // 4
W_C = D_MODEL // 4
W_D = D_MODEL // 4
MIX_WIDTH = W_A + W_B + W_C + W_D
POOL_WINDOWS = (2, 4, 8, 16)
N_POOL = 4
POOL_GW = W_A // N_POOL
POOL_HIST = 15
H_B = 4
DH_B = W_B // H_B
BAND_CHUNKS = 8
ATTN_WINDOW = BAND_CHUNKS * CHUNK
REL_CLIP = 256
H_C = 4
DK_C = W_C // H_C
DV_C = W_C // H_C
CONV_W = 4
QKV_C = 3 * W_C
H_D = 4
DK_D = W_D // (2 * H_D)
DV_D = W_D // H_D
WK_D = H_D * DK_D
GLA_RANK = 16
GLA_GATE_NORM = 16.0
D_FF = 4 * D_MODEL
EPS = 1e-6
NEG_INF = -1e30
PROJ_SIZES = (W_A, 3 * W_B, QKV_C, W_C, H_C, H_C, WK_D, WK_D, W_D, W_D, GLA_RANK)
IN_COLS = W_A + 3 * W_B + QKV_C + W_C + 2 * H_C + 2 * WK_D + 2 * W_D + GLA_RANK

kernel_name = 'hybrid_streaming_encoder_step'


def _rmsnorm(x, g):
    xf = x.astype(jnp.float32)
    y = xf * lax.rsqrt(jnp.mean(xf * xf, axis=-1, keepdims=True) + EPS)
    return (y * g.astype(jnp.float32)).astype(x.dtype)


def _l2norm(x):
    return x * lax.rsqrt(jnp.sum(x * x, axis=-1, keepdims=True) + EPS)


def _split_cols(p):
    parts, off = [], 0
    for n in PROJ_SIZES:
        parts.append(p[..., off:off + n])
        off += n
    return parts


def _rel_bias(table, rel):
    idx = jnp.clip(rel, -REL_CLIP, REL_CLIP) + REL_CLIP
    return table.astype(jnp.float32)[:, idx]


def _to_chunks(t, cs):
    b, n = t.shape[0], t.shape[1] // cs
    t = t.reshape((b, n, cs) + t.shape[2:])
    return jnp.transpose(t, (1, 0, 3, 2) + tuple(range(4, t.ndim)))


def _from_chunks(t):
    n, b, h, cs = t.shape[:4]
    t = jnp.transpose(t, (1, 0, 3, 2) + tuple(range(4, t.ndim)))
    return t.reshape((b, n * cs, h) + t.shape[4:])


def _pool_mixer(u, hist, pos0, w_pool, scale):
    b, t = u.shape[:2]
    ext = jnp.concatenate([hist.astype(u.dtype), u], axis=1)
    ef = ext.astype(jnp.float32)
    c0 = jnp.concatenate([jnp.zeros((b, 1, W_A), jnp.float32), jnp.cumsum(ef, axis=1)], axis=1)
    pos = pos0 + jnp.arange(t)
    groups = []
    for gi, win in enumerate(POOL_WINDOWS):
        lo, hi = gi * POOL_GW, (gi + 1) * POOL_GW
        wsum = (c0[:, POOL_HIST + 1:POOL_HIST + 1 + t, lo:hi]
                - c0[:, POOL_HIST + 1 - win:POOL_HIST + 1 - win + t, lo:hi])
        cnt = jnp.minimum(win, pos + 1).astype(jnp.float32)[None, :, None]
        groups.append(wsum / cnt - ef[:, POOL_HIST:, lo:hi])
    pooled = jnp.stack(groups, axis=2)
    y = jnp.einsum('btgc,gcd->btgd', pooled, w_pool.astype(jnp.float32)).reshape(b, t, W_A)
    return (y * scale.astype(jnp.float32)).astype(u.dtype), ext[:, -POOL_HIST:]


def _band_attention_prompt(q, k, v, table):
    b, t = q.shape[:2]
    nc = t // CHUNK
    nb = BAND_CHUNKS + 1
    qc, kc, vc = (a.astype(jnp.float32).reshape(b, nc, CHUNK, H_B, DH_B) for a in (q, k, v))
    pad = ((0, 0), (BAND_CHUNKS, 0), (0, 0), (0, 0), (0, 0))
    kp, vp = jnp.pad(kc, pad), jnp.pad(vc, pad)
    kband = jnp.concatenate([kp[:, j:j + nc] for j in range(nb)], axis=2)
    vband = jnp.concatenate([vp[:, j:j + nc] for j in range(nb)], axis=2)
    qi = jnp.arange(CHUNK)
    kj = jnp.arange(nb * CHUNK)
    bias = _rel_bias(table, kj[None, :] - BAND_CHUNKS * CHUNK - qi[:, None])
    kpos = (jnp.arange(nc)[:, None] - BAND_CHUNKS) * CHUNK + kj[None, :]
    s = jnp.einsum('bnqhd,bnkhd->bnhqk', qc, kband) * (DH_B ** -0.5) + bias[None, None]
    s = jnp.where((kpos >= 0)[None, :, None, None, :], s, NEG_INF)
    p = jax.nn.softmax(s, axis=-1)
    o = jnp.einsum('bnhqk,bnkhd->bnqhd', p, vband)
    return o.reshape(b, t, W_B).astype(q.dtype)


def _attention_sample(q, k, v, k_cache, v_cache, table):
    b, t = q.shape[:2]
    n_cache = k_cache.shape[2]
    kall = jnp.concatenate([k_cache.astype(jnp.float32), jnp.transpose(k, (0, 2, 1, 3)).astype(jnp.float32)], axis=2)
    vall = jnp.concatenate([v_cache.astype(jnp.float32), jnp.transpose(v, (0, 2, 1, 3)).astype(jnp.float32)], axis=2)
    bias = _rel_bias(table, jnp.arange(n_cache + t)[None, :] - n_cache - jnp.arange(t)[:, None])
    s = jnp.einsum('bqhd,bhkd->bhqk', q.astype(jnp.float32), kall) * (DH_B ** -0.5) + bias[None]
    p = jax.nn.softmax(s, axis=-1)
    o = jnp.einsum('bhqk,bhkd->bqhd', p, vall)
    return o.reshape(b, t, W_B).astype(q.dtype)


def _gated_delta_chunked(q, k, v, g, beta, s0):
    t = q.shape[1]
    cs = min(CHUNK, t)
    xs = tuple(_to_chunks(a, cs) for a in (q, k, v, g, beta))
    incl = jnp.tril(jnp.ones((cs, cs), dtype=bool))
    strict = jnp.tril(jnp.ones((cs, cs), dtype=bool), -1)
    eye = jnp.eye(cs, dtype=jnp.float32)

    def step(S, inp):
        qc, kc, vc, gc, bc = inp
        dv = vc.shape[-1]
        G = jnp.cumsum(gc, axis=-1)
        diff = G[..., :, None] - G[..., None, :]
        dec = jnp.where(incl, jnp.exp(jnp.where(incl, diff, 0.0)), 0.0)
        A = jnp.where(strict, bc[..., :, None] * jnp.einsum('bhid,bhjd->bhij', kc, kc) * dec, 0.0)
        rhs = jnp.concatenate([bc[..., None] * vc, (bc * jnp.exp(G))[..., None] * kc], axis=-1)
        sol = lax.linalg.triangular_solve(A + eye, rhs, left_side=True, lower=True, unit_diagonal=True)
        u, w = sol[..., :dv], sol[..., dv:]
        un = u - jnp.einsum('bhik,bhkv->bhiv', w, S)
        qk = jnp.einsum('bhik,bhjk->bhij', qc, kc) * dec
        o = (jnp.einsum('bhik,bhkv->bhiv', qc * jnp.exp(G)[..., None], S)
             + jnp.einsum('bhij,bhjv->bhiv', qk, un))
        gl = G[..., -1:]
        S = (jnp.exp(gl)[..., None] * S
             + jnp.einsum('bhjk,bhjv->bhkv', kc * jnp.exp(gl - G)[..., None], un))
        return S, o

    s_fin, o = lax.scan(step, s0, xs)
    return _from_chunks(o), s_fin


def _gla_chunked(q, k, v, gk, s0):
    t = q.shape[1]
    cs = min(CHUNK, t)
    xs = tuple(_to_chunks(a, cs) for a in (q, k, v, gk))
    incl = jnp.tril(jnp.ones((cs, cs), dtype=bool))[:, :, None]

    def step(S, inp):
        qc, kc, vc, gc = inp
        G = jnp.cumsum(gc, axis=2)
        diff = G[:, :, :, None, :] - G[:, :, None, :, :]
        dec = jnp.where(incl, jnp.exp(jnp.where(incl, diff, 0.0)), 0.0)
        att = jnp.einsum('bhik,bhjk,bhijk->bhij', qc, kc, dec)
        o = (jnp.einsum('bhik,bhkv->bhiv', qc * jnp.exp(G), S)
             + jnp.einsum('bhij,bhjv->bhiv', att, vc))
        gl = G[:, :, -1:, :]
        S = (jnp.exp(gl[:, :, 0, :])[..., None] * S
             + jnp.einsum('bhjk,bhjv->bhkv', kc * jnp.exp(gl - G), vc))
        return S, o

    s_fin, o = lax.scan(step, s0, xs)
    return _from_chunks(o), s_fin


def _delta_mixer(qkv, z, a, bb, conv_hist, s0, conv_w, a_log, dt_bias, norm_g):
    b, t = qkv.shape[:2]
    ext = jnp.concatenate([conv_hist.astype(qkv.dtype), qkv], axis=1)
    acc = ext[:, 0:t] * conv_w[0]
    for j in range(1, CONV_W):
        acc = acc + ext[:, j:j + t] * conv_w[j]
    c = jax.nn.silu(acc.astype(jnp.float32))
    q = _l2norm(c[..., :W_C].reshape(b, t, H_C, DK_C)) * (DK_C ** -0.5)
    k = _l2norm(c[..., W_C:2 * W_C].reshape(b, t, H_C, DK_C))
    v = c[..., 2 * W_C:].reshape(b, t, H_C, DV_C)
    beta = jax.nn.sigmoid(bb.astype(jnp.float32))
    g = -jnp.exp(a_log.astype(jnp.float32)) * jax.nn.softplus(a.astype(jnp.float32) + dt_bias.astype(jnp.float32))
    o, s_new = _gated_delta_chunked(q, k, v, g, beta, s0.astype(jnp.float32))
    o = _rmsnorm(o, norm_g) * jax.nn.silu(z.astype(jnp.float32).reshape(b, t, H_C, DV_C))
    return o.reshape(b, t, W_C).astype(qkv.dtype), ext[:, -(CONV_W - 1):], s_new


def _gla_mixer(q, k, v, gate, gk_low, s0, w_gk, b_gk, norm_g):
    b, t = q.shape[:2]
    gk = jax.nn.log_sigmoid(jnp.einsum('btr,rk->btk', gk_low.astype(jnp.float32), w_gk.astype(jnp.float32))
                            + b_gk.astype(jnp.float32)) / GLA_GATE_NORM
    qh = q.astype(jnp.float32).reshape(b, t, H_D, DK_D) * (DK_D ** -0.5)
    kh = k.astype(jnp.float32).reshape(b, t, H_D, DK_D)
    vh = v.astype(jnp.float32).reshape(b, t, H_D, DV_D)
    o, s_new = _gla_chunked(qh, kh, vh, gk.reshape(b, t, H_D, DK_D), s0.astype(jnp.float32))
    o = _rmsnorm(o, norm_g) * jax.nn.silu(gate.astype(jnp.float32).reshape(b, t, H_D, DV_D))
    return o.reshape(b, t, W_D).astype(q.dtype), s_new


def _trunk(x, pos0, pool_h, kv_h, conv_h, sd_h, sg_h, w):
    (attn_norm_g, w_in, pool_w, pool_scale, rel_bias, conv_w, a_log, dt_bias, delta_norm_g,
     gla_w_gk, gla_b_gk, gla_norm_g, w_out, mlp_norm_g, w_up, w_down, final_norm_g) = w
    b, t = x.shape[:2]
    new_pool, new_k, new_v, new_conv, new_sd, new_sg = [], [], [], [], [], []
    for l in range(DEPTH):
        h = _rmsnorm(x, attn_norm_g[l])
        (u_a, qkv_b, qkv_c, z_c, a_c, b_c, q_d, k_d, v_d, g_d, gk_d) = _split_cols(
            jnp.einsum('btd,dc->btc', h, w_in[l]))
        y_a, st_pool = _pool_mixer(u_a, pool_h[l], pos0, pool_w[l], pool_scale[l])
        q_b, k_b, v_b = (qkv_b[..., i * W_B:(i + 1) * W_B].reshape(b, t, H_B, DH_B) for i in range(3))
        if kv_h is None:
            y_b = _band_attention_prompt(q_b, k_b, v_b, rel_bias[l])
            keep = min(ATTN_WINDOW, t)
            k_rows, v_rows = k_b[:, t - keep:], v_b[:, t - keep:]
        else:
            y_b = _attention_sample(q_b, k_b, v_b, kv_h[0][l], kv_h[1][l], rel_bias[l])
            k_rows, v_rows = k_b, v_b
        y_c, st_conv, st_d = _delta_mixer(qkv_c, z_c, a_c, b_c, conv_h[l], sd_h[l], conv_w[l],
                                          a_log[l], dt_bias[l], delta_norm_g[l])
        y_d, st_g = _gla_mixer(q_d, k_d, v_d, g_d, gk_d, sg_h[l], gla_w_gk[l], gla_b_gk[l], gla_norm_g[l])
        mix = jnp.concatenate([y_a, y_b, y_c, y_d], axis=-1)
        x = x + jnp.einsum('btc,cd->btd', mix, w_out[l])
        h2 = _rmsnorm(x, mlp_norm_g[l])
        up = jnp.square(jax.nn.relu(jnp.einsum('btd,df->btf', h2, w_up[l])))
        x = x + jnp.einsum('btf,fd->btd', up, w_down[l])
        new_pool.append(st_pool.astype(x.dtype))
        new_k.append(jnp.transpose(k_rows, (0, 2, 1, 3)))
        new_v.append(jnp.transpose(v_rows, (0, 2, 1, 3)))
        new_conv.append(st_conv.astype(x.dtype))
        new_sd.append(st_d.astype(x.dtype))
        new_sg.append(st_g.astype(x.dtype))
    y = _rmsnorm(x, final_norm_g)
    return (y, jnp.stack(new_pool), jnp.stack(new_k), jnp.stack(new_v),
            jnp.stack(new_conv), jnp.stack(new_sd), jnp.stack(new_sg))


def setup_inputs(seed: int = 0) -> dict:
    key = jax.random.key(seed)
    ks = jax.random.split(key, 32)
    f32 = jnp.float32

    def nrm(i, shape, scale):
        return scale * jax.random.normal(ks[i], shape, f32)

    l_b = min(ATTN_WINDOW, PAST_LEN)
    dt = jnp.exp(jax.random.uniform(ks[20], (DEPTH, H_C), f32, math.log(1e-3), math.log(1e-1)))
    return {
        'x_prompt': nrm(0, (BATCH, SEQ, D_MODEL), 1.0),
        'x_sample': nrm(1, (DEC_BATCH, DEC_SEQ, D_MODEL), 1.0),
        'cache_pool': nrm(2, (DEPTH, DEC_BATCH, POOL_HIST, W_A), 1.0),
        'cache_attn_k': nrm(3, (DEPTH, DEC_BATCH, H_B, l_b, DH_B), 1.0),
        'cache_attn_v': nrm(4, (DEPTH, DEC_BATCH, H_B, l_b, DH_B), 1.0),
        'state_conv': nrm(5, (DEPTH, DEC_BATCH, CONV_W - 1, QKV_C), 1.0),
        'state_delta': nrm(6, (DEPTH, DEC_BATCH, H_C, DK_C, DV_C), DK_C ** -0.5),
        'state_gla': nrm(7, (DEPTH, DEC_BATCH, H_D, DK_D, DV_D), 1.0),
        'attn_norm_g': 1.0 + nrm(8, (DEPTH, D_MODEL), 0.05),
        'w_in': nrm(9, (DEPTH, D_MODEL, IN_COLS), D_MODEL ** -0.5),
        'pool_w': nrm(10, (DEPTH, N_POOL, POOL_GW, POOL_GW), POOL_GW ** -0.5),
        'pool_scale': 1.0 + nrm(11, (DEPTH, W_A), 0.1),
        'rel_bias': nrm(12, (DEPTH, H_B, 2 * REL_CLIP + 1), 0.5),
        'conv_w': nrm(13, (DEPTH, CONV_W, QKV_C), CONV_W ** -0.5),
        'a_log': jnp.log(jax.random.uniform(ks[14], (DEPTH, H_C), f32, 1.0, 16.0)),
        'dt_bias': dt + jnp.log(-jnp.expm1(-dt)),
        'delta_norm_g': 1.0 + nrm(15, (DEPTH, DV_C), 0.05),
        'gla_w_gk': nrm(16, (DEPTH, GLA_RANK, WK_D), GLA_RANK ** -0.5),
        'gla_b_gk': nrm(17, (DEPTH, WK_D), 0.1),
        'gla_norm_g': 1.0 + nrm(18, (DEPTH, DV_D), 0.05),
        'w_out': nrm(19, (DEPTH, MIX_WIDTH, D_MODEL), MIX_WIDTH ** -0.5),
        'mlp_norm_g': 1.0 + nrm(21, (DEPTH, D_MODEL), 0.05),
        'w_up': nrm(22, (DEPTH, D_MODEL, D_FF), D_MODEL ** -0.5),
        'w_down': nrm(23, (DEPTH, D_FF, D_MODEL), 0.5 * D_FF ** -0.5),
        'final_norm_g': 1.0 + nrm(24, (D_MODEL,), 0.05),
    }


def reference(x_prompt, x_sample, cache_pool, cache_attn_k, cache_attn_v, state_conv, state_delta,
              state_gla, attn_norm_g, w_in, pool_w, pool_scale, rel_bias, conv_w, a_log, dt_bias,
              delta_norm_g, gla_w_gk, gla_b_gk, gla_norm_g, w_out, mlp_norm_g, w_up, w_down,
              final_norm_g):
    w = (attn_norm_g, w_in, pool_w, pool_scale, rel_bias, conv_w, a_log, dt_bias, delta_norm_g,
         gla_w_gk, gla_b_gk, gla_norm_g, w_out, mlp_norm_g, w_up, w_down, final_norm_g)
    bp = x_prompt.shape[0]
    dtp = x_prompt.dtype
    y_prompt, pool_p, k_p, v_p, conv_p, delta_p, gla_p = _trunk(
        x_prompt, 0,
        jnp.zeros((DEPTH, bp, POOL_HIST, W_A), dtp), None,
        jnp.zeros((DEPTH, bp, CONV_W - 1, QKV_C), dtp),
        jnp.zeros((DEPTH, bp, H_C, DK_C, DV_C), dtp),
        jnp.zeros((DEPTH, bp, H_D, DK_D, DV_D), dtp), w)
    y_sample, pool_s, k_s, v_s, conv_s, delta_s, gla_s = _trunk(
        x_sample, PAST_LEN, cache_pool, (cache_attn_k, cache_attn_v), state_conv,
        state_delta, state_gla, w)
    return (y_prompt, y_sample, pool_p, k_p, v_p, conv_p, delta_p, gla_p,
            pool_s, k_s, v_s, conv_s, delta_s, gla_s)
```

```cpp
#include <hip/hip_runtime.h>
#include <hip/hip_cooperative_groups.h>
#include <cstdio>
#include <cstdint>
namespace cg = cooperative_groups;

#ifndef ONE_LAUNCH
#define ONE_LAUNCH 1
#endif

typedef unsigned short bf16_t;
typedef short bf16x8 __attribute__((ext_vector_type(8)));
typedef float f32x4 __attribute__((ext_vector_type(4)));
typedef unsigned u32x4 __attribute__((ext_vector_type(4)));

constexpr int DM = 1024, NTOK = 17408, NPROMPT = 16384, PC = 2944, INC = 2840, DFF = 4096, DEPTH = 4;
constexpr int C_UA = 0, C_QB = 256, C_KB = 512, C_VB = 768, C_QC = 1024, C_ZC = 1792, C_AC = 2048, C_BC = 2052,
              C_QD = 2056, C_KD = 2184, C_VD = 2312, C_GD = 2568, C_GK = 2824;
constexpr int NITEM = 1152;
constexpr float EPSV = 1e-6f;
constexpr int LDS_BYTES = 77824;

constexpr size_t WB_IN = 0, WB_OUT = (size_t)PC * DM, WB_UP = WB_OUT + (size_t)DM * DM, WB_DN = WB_UP + (size_t)DFF * DM,
                 WB_ELEMS = WB_DN + (size_t)DM * DFF;
constexpr size_t OFF_WB0 = 0, OFF_WB1 = WB_ELEMS * 2, OFF_XRES = OFF_WB1 + WB_ELEMS * 2, OFF_XB = OFF_XRES + (size_t)NTOK * DM * 4,
                 OFF_SSQ = OFF_XB + (size_t)NTOK * DM * 2, OFF_REG = OFF_SSQ + (size_t)16 * NTOK * 4;
constexpr size_t R_P = 0, R_MIX = R_P + (size_t)NTOK * PC * 2, R_DM = R_MIX + (size_t)NTOK * DM * 2, R_DN = R_DM + (size_t)NITEM * 16384,
                 R_DR = R_DN + (size_t)NITEM * 16384, R_DO0 = R_DR + (size_t)NITEM * 8192, R_DS = R_DO0 + (size_t)NITEM * 8192,
                 R_GN = R_DS + (size_t)NITEM * 16384, R_GQ = R_GN + (size_t)NITEM * 8192, R_GO0 = R_GQ + (size_t)NITEM * 4096,
                 R_GD = R_GO0 + (size_t)NITEM * 8192, R_GS = R_GD + (size_t)NITEM * 128, R_END = R_GS + (size_t)NITEM * 8192;
constexpr size_t WS_NEED = OFF_REG + R_END;
static_assert((size_t)NTOK * DFF * 2 <= R_END, "up overlay");
constexpr size_t O_YP = 0, O_YS = 16777216, O_POOLP = O_YS + 1048576, O_KP = O_POOLP + 122880, O_VP = O_KP + 4194304, O_CONVP = O_VP + 4194304,
                 O_DELTAP = O_CONVP + 73728, O_GLAP = O_DELTAP + 524288, O_POOLS = O_GLAP + 262144, O_KS = O_POOLS + 491520, O_VS = O_KS + 1048576,
                 O_CONVS = O_VS + 1048576, O_DELTAS = O_CONVS + 294912, O_GLAS = O_DELTAS + 2097152;

struct Params {
    const float *x_prompt, *x_sample, *cache_pool, *cache_k, *cache_v, *state_conv, *state_delta, *state_gla;
    const float *attn_norm_g, *w_in, *pool_w, *pool_scale, *rel_bias, *conv_w, *a_log, *dt_bias, *delta_norm_g, *gla_w_gk, *gla_b_gk,
        *gla_norm_g, *w_out, *mlp_norm_g, *w_up, *w_down, *final_norm_g;
    float* out;
    char* ws;
    int ph_begin, ph_end;
};

__device__ __forceinline__ float bf2f(bf16_t v) { return __uint_as_float(((unsigned)v) << 16); }
__device__ __forceinline__ bf16_t f2bf(float f) { unsigned u = __float_as_uint(f); u += 0x7fffu + ((u >> 16) & 1u); return (bf16_t)(u >> 16); }
__device__ __forceinline__ unsigned pack2(float lo, float hi) { return (unsigned)f2bf(lo) | ((unsigned)f2bf(hi) << 16); }
__device__ __forceinline__ float ldf(const float* p) { return *p; }
__device__ __forceinline__ float ldf(const bf16_t* p) { return bf2f(*p); }
__device__ __forceinline__ float wave_sum(float v) {
#pragma unroll
    for (int o = 32; o; o >>= 1) v += __shfl_xor(v, o);
    return v;
}
__device__ __forceinline__ float siluf(float x) { return x / (1.f + expf(-x)); }

template <typename TA, typename TB>
__device__ __forceinline__ f32x4 mm16(const TA* A, int a_rs, int a_cs, const TB* B, int b_rs, int b_cs, int K, f32x4 acc, int lane) {
    const int i = lane & 15, kq = lane >> 4;
    const TA* ap = A + i * a_rs + kq * a_cs;
    const TB* bp = B + kq * b_rs + i * b_cs;
    for (int k0 = 0; k0 < K; k0 += 4) {
        float a = ldf(ap + k0 * a_cs), b = ldf(bp + k0 * b_rs);
        acc = __builtin_amdgcn_mfma_f32_16x16x4f32(a, b, acc, 0, 0, 0);
    }
    return acc;
}

__device__ __forceinline__ int tid_opaque() { int t = threadIdx.x; asm volatile("" : "+v"(t)); return t; }
__device__ __forceinline__ const float* xin_row(const Params& p, int row) {
    return row < NPROMPT ? p.x_prompt + (size_t)row * DM : p.x_sample + (size_t)(row - NPROMPT) * DM;
}

__device__ void convert_tile(const float* __restrict__ src, bf16_t* __restrict__ dst, int K, int N, const float* __restrict__ g, int tile, char* lds) {
    float* T = (float*)lds;
    const int nkt = K >> 6, kt = tile % nkt, nt = tile / nkt, t = tid_opaque();
    __syncthreads();
#pragma unroll
    for (int i = 0; i < 4; ++i) {
        const int kl = (t >> 4) + 16 * i, k = kt * 64 + kl, nl = (t & 15) * 4, n0 = nt * 64 + nl;
        float4 v = make_float4(0.f, 0.f, 0.f, 0.f);
        if (n0 < N) v = *(const float4*)(src + (size_t)k * N + n0);
        if (g) { const float s = g[k]; v.x *= s; v.y *= s; v.z *= s; v.w *= s; }
        T[(nl + 0) * 65 + kl] = v.x; T[(nl + 1) * 65 + kl] = v.y; T[(nl + 2) * 65 + kl] = v.z; T[(nl + 3) * 65 + kl] = v.w;
    }
    __syncthreads();
    const int n = t >> 2, kc = (t & 3) * 16;
    const float* r = T + n * 65 + kc;
    uint4 a, b;
    a.x = pack2(r[0], r[1]); a.y = pack2(r[2], r[3]); a.z = pack2(r[4], r[5]); a.w = pack2(r[6], r[7]);
    b.x = pack2(r[8], r[9]); b.y = pack2(r[10], r[11]); b.z = pack2(r[12], r[13]); b.w = pack2(r[14], r[15]);
    bf16_t* d = dst + (size_t)(nt * 64 + n) * K + kt * 64 + kc;
    *(uint4*)d = a; *(uint4*)(d + 8) = b;
}
constexpr int CV_IN = 16 * 46, CV_OUT = 16 * 16, CV_UP = 16 * 64, CV_DN = 64 * 16, CV_TOTAL = CV_IN + CV_OUT + CV_UP + CV_DN;
__device__ void convert_layer_item(const Params& p, int l, int it, char* lds) {
    bf16_t* wb = (bf16_t*)(p.ws + ((l & 1) ? OFF_WB1 : OFF_WB0));
    if (it < CV_IN) convert_tile(p.w_in + (size_t)l * DM * INC, wb + WB_IN, DM, INC, p.attn_norm_g + l * DM, it, lds);
    else if ((it -= CV_IN) < CV_OUT) convert_tile(p.w_out + (size_t)l * DM * DM, wb + WB_OUT, DM, DM, nullptr, it, lds);
    else if ((it -= CV_OUT) < CV_UP) convert_tile(p.w_up + (size_t)l * DM * DFF, wb + WB_UP, DM, DFF, p.mlp_norm_g + l * DM, it, lds);
    else { it -= CV_UP; convert_tile(p.w_down + (size_t)l * DFF * DM, wb + WB_DN, DFF, DM, nullptr, it, lds); }
}

__device__ void prologue_rows(const Params& p, int it) {
    const int w = tid_opaque() >> 6, lane = tid_opaque() & 63, row = it * 4 + w;
    const float* x = xin_row(p, row);
    float* xres = (float*)(p.ws + OFF_XRES) + (size_t)row * DM;
    bf16_t* xb = (bf16_t*)(p.ws + OFF_XB) + (size_t)row * DM;
    float* ssq = (float*)(p.ws + OFF_SSQ);
    float s = 0.f;
#pragma unroll
    for (int i = 0; i < 4; ++i) {
        const int c = lane * 4 + 256 * i;
        float4 v = *(const float4*)(x + c);
        s += v.x * v.x + v.y * v.y + v.z * v.z + v.w * v.w;
        *(float4*)(xres + c) = v;
        uint2 o; o.x = pack2(v.x, v.y); o.y = pack2(v.z, v.w);
        *(uint2*)(xb + c) = o;
    }
    s = wave_sum(s);
    if (lane < 16) ssq[(size_t)row * 16 + lane] = lane == 0 ? s : 0.f;
}

struct EpiP { bf16_t* obf; int ldo; float* xres; bf16_t* xb; const float* ssq_in; float* ssq_out; };
constexpr int GLD = 72;
template <int EPI>
__device__ void gemm_tile(const bf16_t* __restrict__ A, int lda, const bf16_t* __restrict__ Bt, int K, int tm, int tn, const EpiP& e, char* lds) {
    const int t = tid_opaque(), lane = t & 63, w = t >> 6, wm = w >> 1, wn = w & 1, fr = lane & 15, fq = lane >> 4;
    const int lr = t >> 3, lc = (t & 7) * 8;
    const bf16_t* ag = A + (size_t)(tm * 128 + lr) * lda + lc;
    const bf16_t* bg = Bt + (size_t)(tn * 128 + lr) * K + lc;
    f32x4 acc[4][4];
#pragma unroll
    for (int i = 0; i < 4; ++i)
#pragma unroll
        for (int j = 0; j < 4; ++j) acc[i][j] = (f32x4){0.f, 0.f, 0.f, 0.f};
    u32x4 ra[4], rb[4];
#pragma unroll
    for (int i = 0; i < 4; ++i) { ra[i] = *(const u32x4*)(ag + (size_t)(32 * i) * lda); rb[i] = *(const u32x4*)(bg + (size_t)(32 * i) * K); }
    __syncthreads();
    {
        bf16_t* As = (bf16_t*)lds; bf16_t* Bs = As + 128 * GLD;
#pragma unroll
        for (int i = 0; i < 4; ++i) { *(u32x4*)(As + (lr + 32 * i) * GLD + lc) = ra[i]; *(u32x4*)(Bs + (lr + 32 * i) * GLD + lc) = rb[i]; }
    }
    __syncthreads();
    const int nk = K >> 6;
    for (int kt = 0; kt < nk; ++kt) {
        const bf16_t* As = (const bf16_t*)(lds + (kt & 1) * (256 * GLD * 2)); const bf16_t* Bs = As + 128 * GLD;
        if (kt + 1 < nk) {
#pragma unroll
            for (int i = 0; i < 4; ++i) { ra[i] = *(const u32x4*)(ag + (size_t)(32 * i) * lda + (kt + 1) * 64); rb[i] = *(const u32x4*)(bg + (size_t)(32 * i) * K + (kt + 1) * 64); }
        }
#pragma unroll
        for (int kh = 0; kh < 2; ++kh) {
            bf16x8 af[4], bfr[4];
#pragma unroll
            for (int i = 0; i < 4; ++i) {
                af[i] = *(const bf16x8*)(As + (wm * 64 + i * 16 + fr) * GLD + kh * 32 + fq * 8);
                bfr[i] = *(const bf16x8*)(Bs + (wn * 64 + i * 16 + fr) * GLD + kh * 32 + fq * 8);
            }
#pragma unroll
            for (int i = 0; i < 4; ++i)
#pragma unroll
                for (int j = 0; j < 4; ++j) acc[i][j] = __builtin_amdgcn_mfma_f32_16x16x32_bf16(bfr[j], af[i], acc[i][j], 0, 0, 0);
        }
        if (kt + 1 < nk) {
            bf16_t* An = (bf16_t*)(lds + ((kt + 1) & 1) * (256 * GLD * 2)); bf16_t* Bn = An + 128 * GLD;
#pragma unroll
            for (int i = 0; i < 4; ++i) { *(u32x4*)(An + (lr + 32 * i) * GLD + lc) = ra[i]; *(u32x4*)(Bn + (lr + 32 * i) * GLD + lc) = rb[i]; }
        }
        __syncthreads();
    }
#pragma unroll
    for (int i = 0; i < 4; ++i) {
        const int row = tm * 128 + wm * 64 + i * 16 + fr;
        float rs = 1.f;
        if (EPI == 0 || EPI == 2) {
            const f32x4* pp = (const f32x4*)(e.ssq_in + (size_t)row * 16);
            const f32x4 a = (pp[0] + pp[1]) + (pp[2] + pp[3]);
            rs = rsqrtf(((a[0] + a[1]) + (a[2] + a[3])) * (1.f / DM) + EPSV);
        }
        float sq = 0.f;
#pragma unroll
        for (int j = 0; j < 4; ++j) {
            const int col = tn * 128 + wn * 64 + j * 16 + fq * 4;
            f32x4 v = acc[i][j];
            if (EPI == 0) {
                uint2 o; o.x = pack2(v[0] * rs, v[1] * rs); o.y = pack2(v[2] * rs, v[3] * rs);
                *(uint2*)(e.obf + (size_t)row * e.ldo + col) = o;
            } else if (EPI == 2) {
                float a0 = fmaxf(v[0] * rs, 0.f), a1 = fmaxf(v[1] * rs, 0.f), a2 = fmaxf(v[2] * rs, 0.f), a3 = fmaxf(v[3] * rs, 0.f);
                uint2 o; o.x = pack2(a0 * a0, a1 * a1); o.y = pack2(a2 * a2, a3 * a3);
                *(uint2*)(e.obf + (size_t)row * e.ldo + col) = o;
            } else {
                float4 x = *(const float4*)(e.xres + (size_t)row * DM + col);
                x.x += v[0]; x.y += v[1]; x.z += v[2]; x.w += v[3];
                *(float4*)(e.xres + (size_t)row * DM + col) = x;
                uint2 o; o.x = pack2(x.x, x.y); o.y = pack2(x.z, x.w);
                *(uint2*)(e.xb + (size_t)row * DM + col) = o;
                sq += x.x * x.x + x.y * x.y + x.z * x.z + x.w * x.w;
            }
        }
        if (EPI == 1) {
            sq += __shfl_xor(sq, 16); sq += __shfl_xor(sq, 32);
            if (fq == 0) e.ssq_out[(size_t)row * 16 + tn * 2 + wn] = sq;
        }
    }
}

struct Item { int b, h, c, cs, row0; bool sample; };
__device__ __forceinline__ Item decode_item(int item) {
    Item r;
    if (item < 1024) { r.b = item >> 7; r.h = (item >> 5) & 3; r.c = item & 31; r.cs = 64; r.row0 = r.b * 2048 + r.c * 64; r.sample = false; }
    else { const int s = item - 1024; r.b = s >> 2; r.h = s & 3; r.c = 0; r.cs = 32; r.row0 = NPROMPT + r.b * 32; r.sample = true; }
    return r;
}

__device__ void delta_prep(const Params& p, int l, int item, char* lds) {
    const Item it = decode_item(item);
    const int cs = it.cs, h = it.h, t = tid_opaque(), lane = t & 63, w = t >> 6, fr = lane & 15, fq = lane >> 4;
    float* Ks = (float*)lds;
    float* X = (float*)(lds + 16640);
    float* Am = (float*)(lds + 49664);
    bf16_t* QKm = (bf16_t*)(lds + 66304);
    float* Gs = (float*)(lds + 74752);
    float* Bs = (float*)(lds + 75008);
    const bf16_t* P = (const bf16_t*)(p.ws + OFF_REG + R_P);
    const float* cw = p.conv_w + (size_t)l * 4 * 768;
    const float* hist = p.state_conv + (size_t)(l * 32 + it.b) * 3 * 768;
    __syncthreads();
    for (int e = t; e < cs * 192; e += 256) {
        const int tok = e / 192, ch = e - tok * 192, which = ch >> 6, d = ch & 63, cwi = which * 256 + h * 64 + d, col = C_QC + cwi;
        float acc = 0.f;
#pragma unroll
        for (int j = 0; j < 4; ++j) {
            const int tt = tok - 3 + j;
            float xv;
            if (tt >= 0) xv = bf2f(P[(size_t)(it.row0 + tt) * PC + col]);
            else if (it.sample) xv = hist[(3 + tt) * 768 + cwi];
            else xv = (it.c > 0) ? bf2f(P[(size_t)(it.row0 + tt) * PC + col]) : 0.f;
            acc += xv * cw[j * 768 + cwi];
        }
        const float cv = siluf(acc);
        if (which == 0) X[tok * 129 + 64 + d] = cv; else if (which == 1) Ks[tok * 65 + d] = cv; else X[tok * 129 + d] = cv;
    }
    __syncthreads();
    for (int tok = w; tok < cs; tok += 4) {
        const float kv = Ks[tok * 65 + lane], qv = X[tok * 129 + 64 + lane];
        const float sk = wave_sum(kv * kv), sq = wave_sum(qv * qv);
        Ks[tok * 65 + lane] = kv * rsqrtf(sk + EPSV);
        X[tok * 129 + 64 + lane] = qv * rsqrtf(sq + EPSV) * 0.125f;
    }
    if (t < cs) {
        const float a = bf2f(P[(size_t)(it.row0 + t) * PC + C_AC + h]), bb = bf2f(P[(size_t)(it.row0 + t) * PC + C_BC + h]);
        const float xs = a + p.dt_bias[l * 4 + h];
        const float sp = xs > 20.f ? xs : log1pf(expf(xs));
        Gs[t] = -expf(p.a_log[l * 4 + h]) * sp;
        Bs[t] = 1.f / (1.f + expf(-bb));
    }
    __syncthreads();
    if (w == 0) {
        float v = lane < cs ? Gs[lane] : 0.f;
#pragma unroll
        for (int o = 1; o < 64; o <<= 1) { const float n = __shfl_up(v, o); if (lane >= o) v += n; }
        if (lane < cs) Gs[lane] = v;
    }
    __syncthreads();
    const bool act = (w * 16 < cs);
    f32x4 qreg[4];
    if (act) {
        f32x4 aK[4], aQ[4];
#pragma unroll
        for (int jt = 0; jt < 4; ++jt) {
            aK[jt] = (f32x4){0.f, 0.f, 0.f, 0.f}; aQ[jt] = aK[jt];
            if (jt * 16 < cs) {
                aK[jt] = mm16(Ks + w * 16 * 65, 65, 1, Ks + jt * 16 * 65, 1, 65, 64, aK[jt], lane);
                aQ[jt] = mm16(X + w * 16 * 129 + 64, 129, 1, Ks + jt * 16 * 65, 1, 65, 64, aQ[jt], lane);
            }
        }
#pragma unroll
        for (int nt = 0; nt < 4; ++nt)
#pragma unroll
            for (int r = 0; r < 4; ++r) { const int i = w * 16 + fq * 4 + r; qreg[nt][r] = X[i * 129 + 64 + nt * 16 + fr] * expf(Gs[i]); }
#pragma unroll
        for (int jt = 0; jt < 4; ++jt)
            if (jt * 16 < cs) {
#pragma unroll
                for (int r = 0; r < 4; ++r) {
                    const int i = w * 16 + fq * 4 + r, j = jt * 16 + fr;
                    const float dec = (j <= i) ? expf(Gs[i] - Gs[j]) : 0.f;
                    Am[i * 65 + j] = (j < i) ? Bs[i] * aK[jt][r] * dec : 0.f;
                    QKm[i * 66 + j] = f2bf(aQ[jt][r] * dec);
                }
            }
    }
    __syncthreads();
    for (int e = t; e < cs * 64; e += 256) {
        const int i = e >> 6, d = e & 63;
        const float b = Bs[i];
        X[i * 129 + 64 + d] = b * expf(Gs[i]) * Ks[i * 65 + d];
        X[i * 129 + d] *= b;
    }
    __syncthreads();
    if (t < 128) {
        for (int i = 1; i < cs; ++i) {
            float s = X[i * 129 + t];
            const float* ar = Am + i * 65;
            for (int j = 0; j < i; ++j) s -= ar[j] * X[j * 129 + t];
            X[i * 129 + t] = s;
        }
    }
    __syncthreads();
    const float gl = Gs[cs - 1];
    for (int e = t; e < cs * 64; e += 256) { const int i = e >> 6, d = e & 63; Ks[i * 65 + d] *= expf(gl - Gs[i]); }
    __syncthreads();
    float* oM = (float*)(p.ws + OFF_REG + R_DM) + (size_t)item * 4096;
    float* oN = (float*)(p.ws + OFF_REG + R_DN) + (size_t)item * 4096;
    bf16_t* oR = (bf16_t*)(p.ws + OFF_REG + R_DR) + (size_t)item * 4096;
    bf16_t* oO = (bf16_t*)(p.ws + OFF_REG + R_DO0) + (size_t)item * 4096;
    const float egl = expf(gl);
#pragma unroll
    for (int bt = 0; bt < 4; ++bt) {
        f32x4 z = (f32x4){0.f, 0.f, 0.f, 0.f};
        f32x4 cm = mm16(Ks + w * 16, 1, 65, X + 64 + bt * 16, 129, 1, cs, z, lane);
        f32x4 cn = mm16(Ks + w * 16, 1, 65, X + bt * 16, 129, 1, cs, z, lane);
#pragma unroll
        for (int r = 0; r < 4; ++r) {
            const int a = w * 16 + fq * 4 + r, b = bt * 16 + fr;
            oM[a * 64 + b] = ((a == b) ? egl : 0.f) - cm[r];
            oN[a * 64 + b] = cn[r];
        }
    }
    if (act) {
#pragma unroll
        for (int bt = 0; bt < 4; ++bt) {
            f32x4 z = (f32x4){0.f, 0.f, 0.f, 0.f};
            f32x4 cr = mm16(QKm + w * 16 * 66, 66, 1, X + 64 + bt * 16, 129, 1, cs, z, lane);
            f32x4 co = mm16(QKm + w * 16 * 66, 66, 1, X + bt * 16, 129, 1, cs, z, lane);
#pragma unroll
            for (int r = 0; r < 4; ++r) {
                const int i = w * 16 + fq * 4 + r, b = bt * 16 + fr;
                oR[i * 64 + b] = f2bf(qreg[bt][r] - cr[r]);
                oO[i * 64 + b] = f2bf(co[r]);
            }
        }
    }
}

__device__ void gla_prep(const Params& p, int l, int item, char* lds) {
    const Item it = decode_item(item);
    const int cs = it.cs, h = it.h, t = tid_opaque(), lane = t & 63, w = t >> 6, fr = lane & 15, fq = lane >> 4;
    float* Qg = (float*)lds;
    float* Kn = (float*)(lds + 8448);
    float* Kd = (float*)(lds + 16896);
    float* Gs = (float*)(lds + 25344);
    float* Vs = (float*)(lds + 33792);
    float* Att = (float*)(lds + 50432);
    const bf16_t* P = (const bf16_t*)(p.ws + OFF_REG + R_P);
    __syncthreads();
    for (int e = t; e < cs * 32; e += 256) {
        const int tok = e >> 5, kk = e & 31;
        const bf16_t* pr = P + (size_t)(it.row0 + tok) * PC;
        Qg[tok * 33 + kk] = bf2f(pr[C_QD + h * 32 + kk]);
        Kn[tok * 33 + kk] = bf2f(pr[C_KD + h * 32 + kk]);
        float x = p.gla_b_gk[l * 128 + h * 32 + kk];
#pragma unroll
        for (int r = 0; r < 16; ++r) x += bf2f(pr[C_GK + r]) * p.gla_w_gk[(size_t)(l * 16 + r) * 128 + h * 32 + kk];
        const float ls = fminf(x, 0.f) - log1pf(expf(-fabsf(x)));
        Gs[tok * 33 + kk] = ls * (1.f / 16.f);
    }
    for (int e = t; e < cs * 64; e += 256) {
        const int tok = e >> 6, d = e & 63;
        Vs[tok * 65 + d] = bf2f(P[(size_t)(it.row0 + tok) * PC + C_VD + h * 64 + d]);
    }
    __syncthreads();
    if (t < 32) { float s = 0.f; for (int tok = 0; tok < cs; ++tok) { s += Gs[tok * 33 + t]; Gs[tok * 33 + t] = s; } }
    __syncthreads();
    bf16_t* oQ = (bf16_t*)(p.ws + OFF_REG + R_GQ) + (size_t)item * 2048;
    for (int e = t; e < cs * 32; e += 256) {
        const int tok = e >> 5, kk = e & 31;
        const float G = Gs[tok * 33 + kk], gl = Gs[(cs - 1) * 33 + kk], q = Qg[tok * 33 + kk], k = Kn[tok * 33 + kk];
        const float qg = q * 0.17677669529663687f * expf(G);
        Qg[tok * 33 + kk] = qg; Kn[tok * 33 + kk] = k * expf(-G); Kd[tok * 33 + kk] = k * expf(gl - G);
        oQ[tok * 32 + kk] = f2bf(qg);
    }
    if (t < 32) ((float*)(p.ws + OFF_REG + R_GD))[(size_t)item * 32 + t] = expf(Gs[(cs - 1) * 33 + t]);
    __syncthreads();
    const bool act = (w * 16 < cs);
    if (act) {
#pragma unroll
        for (int jt = 0; jt < 4; ++jt)
            if (jt * 16 < cs) {
                f32x4 z = (f32x4){0.f, 0.f, 0.f, 0.f};
                f32x4 a = mm16(Qg + w * 16 * 33, 33, 1, Kn + jt * 16 * 33, 1, 33, 32, z, lane);
#pragma unroll
                for (int r = 0; r < 4; ++r) { const int i = w * 16 + fq * 4 + r, j = jt * 16 + fr; Att[i * 65 + j] = (j <= i) ? a[r] : 0.f; }
            }
    }
    float* oN = (float*)(p.ws + OFF_REG + R_GN) + (size_t)item * 2048;
#pragma unroll
    for (int q2 = 0; q2 < 2; ++q2) {
        const int tile = w + 4 * q2, at = tile >> 2, vt = tile & 3;
        f32x4 z = (f32x4){0.f, 0.f, 0.f, 0.f};
        f32x4 cn = mm16(Kd + at * 16, 1, 33, Vs + vt * 16, 65, 1, cs, z, lane);
#pragma unroll
        for (int r = 0; r < 4; ++r) oN[(at * 16 + fq * 4 + r) * 64 + vt * 16 + fr] = cn[r];
    }
    __syncthreads();
    if (act) {
        bf16_t* oO = (bf16_t*)(p.ws + OFF_REG + R_GO0) + (size_t)item * 4096;
#pragma unroll
        for (int vt = 0; vt < 4; ++vt) {
            f32x4 z = (f32x4){0.f, 0.f, 0.f, 0.f};
            f32x4 co = mm16(Att + w * 16 * 65, 65, 1, Vs + vt * 16, 65, 1, cs, z, lane);
#pragma unroll
            for (int r = 0; r < 4; ++r) oO[(w * 16 + fq * 4 + r) * 64 + vt * 16 + fr] = f2bf(co[r]);
        }
    }
}

__device__ void delta_scan(const Params& p, int l, int idx, char* lds) {
    const int t = tid_opaque(), lane = t & 63, w = t >> 6, fr = lane & 15, fq = lane >> 4;
    float* Sl = (float*)lds;
    int item0, nsteps, v0; float* outp; const float* s0 = nullptr;
    if (idx < 128) { const int bh = idx >> 2; v0 = (idx & 3) * 16; item0 = bh * 32; nsteps = 32; outp = p.out + O_DELTAP + ((size_t)l * 32 + bh) * 4096; }
    else { const int s = idx - 128, bh = s >> 2; v0 = (s & 3) * 16; item0 = 1024 + bh; nsteps = 1; outp = p.out + O_DELTAS + ((size_t)l * 128 + bh) * 4096;
           s0 = p.state_delta + ((size_t)l * 128 + bh) * 4096; }
    const float* gM = (const float*)(p.ws + OFF_REG + R_DM);
    const float* gN = (const float*)(p.ws + OFF_REG + R_DN);
    float* gS = (float*)(p.ws + OFF_REG + R_DS);
    f32x4 sreg;
#pragma unroll
    for (int r = 0; r < 4; ++r) sreg[r] = s0 ? s0[(w * 16 + fq * 4 + r) * 64 + v0 + fr] : 0.f;
    __syncthreads();
#pragma unroll
    for (int r = 0; r < 4; ++r) Sl[(w * 16 + fq * 4 + r) * 17 + fr] = sreg[r];
    __syncthreads();
    for (int c = 0; c < nsteps; ++c) {
        const size_t ib = (size_t)(item0 + c) * 4096;
        float aM[16];
#pragma unroll
        for (int kk = 0; kk < 16; ++kk) aM[kk] = gM[ib + (w * 16 + fr) * 64 + kk * 4 + fq];
        f32x4 acc;
#pragma unroll
        for (int r = 0; r < 4; ++r) { const int a = w * 16 + fq * 4 + r; acc[r] = gN[ib + a * 64 + v0 + fr]; gS[ib + a * 64 + v0 + fr] = sreg[r]; }
#pragma unroll
        for (int kk = 0; kk < 16; ++kk) acc = __builtin_amdgcn_mfma_f32_16x16x4f32(aM[kk], Sl[(kk * 4 + fq) * 17 + fr], acc, 0, 0, 0);
        __syncthreads();
        sreg = acc;
#pragma unroll
        for (int r = 0; r < 4; ++r) Sl[(w * 16 + fq * 4 + r) * 17 + fr] = sreg[r];
        __syncthreads();
    }
#pragma unroll
    for (int r = 0; r < 4; ++r) outp[(w * 16 + fq * 4 + r) * 64 + v0 + fr] = sreg[r];
}

__device__ void gla_scan(const Params& p, int l, int idx) {
    const int t = tid_opaque();
    int item0, nsteps, e; float* outp; float S = 0.f;
    if (idx < 256) { const int bh = idx >> 3; e = (idx & 7) * 256 + t; item0 = bh * 32; nsteps = 32; outp = p.out + O_GLAP + ((size_t)l * 32 + bh) * 2048; }
    else { const int s = idx - 256, bh = s >> 3; e = (s & 7) * 256 + t; item0 = 1024 + bh; nsteps = 1; outp = p.out + O_GLAS + ((size_t)l * 128 + bh) * 2048;
           S = p.state_gla[((size_t)l * 128 + bh) * 2048 + e]; }
    const float* gN = (const float*)(p.ws + OFF_REG + R_GN);
    const float* gD = (const float*)(p.ws + OFF_REG + R_GD);
    float* gS = (float*)(p.ws + OFF_REG + R_GS);
    const int a = e >> 6;
    for (int c = 0; c < nsteps; ++c) {
        const size_t ib = (size_t)(item0 + c);
        gS[ib * 2048 + e] = S;
        S = gD[ib * 32 + a] * S + gN[ib * 2048 + e];
    }
    outp[e] = S;
}

__device__ void attn_item(const Params& p, int l, int item, char* lds) {
    bf16_t* Ks = (bf16_t*)lds;
    bf16_t* Vt = (bf16_t*)(lds + 9216);
    float* bias = (float*)(lds + 18432);
    const bf16_t* P = (const bf16_t*)(p.ws + OFF_REG + R_P);
    bf16_t* mix = (bf16_t*)(p.ws + OFF_REG + R_MIX);
    const int t = tid_opaque(), lane = t & 63, w = t >> 6, fr = lane & 15, fq = lane >> 4;
    int b, h, c = 0, nq, qrow0, nkb, kb0 = 0; bool sample;
    if (item < 1024) { b = item >> 7; c = (item >> 2) & 31; h = item & 3; nq = 64; qrow0 = b * 2048 + c * 64; kb0 = c > 8 ? c - 8 : 0; nkb = c - kb0 + 1; sample = false; }
    else { const int s = item - 1024; b = s >> 2; h = s & 3; nq = 32; qrow0 = NPROMPT + b * 32; nkb = 9; sample = true; }
    __syncthreads();
    for (int i = t; i < 513; i += 256) bias[i] = p.rel_bias[(size_t)(l * 4 + h) * 513 + i];
    const bool act = (w * 16 < nq);
    bf16x8 qf0 = {0, 0, 0, 0, 0, 0, 0, 0}, qf1 = qf0;
    if (act) { const bf16_t* qp = P + (size_t)(qrow0 + w * 16 + fr) * PC + C_QB + h * 64 + fq * 8; qf0 = *(const bf16x8*)qp; qf1 = *(const bf16x8*)(qp + 32); }
    float m = -1e30f, lsum = 0.f;
    f32x4 o[4];
#pragma unroll
    for (int i = 0; i < 4; ++i) o[i] = (f32x4){0.f, 0.f, 0.f, 0.f};
    const int qi = w * 16 + fr;
    const int key = t >> 2, dc = (t & 3) * 16;
    for (int kb = 0; kb < nkb; ++kb) {
        int nvalid = 64, relbase;
        uint4 k0, k1, v0, v1;
        if (!sample) {
            relbase = (kb0 + kb - c) * 64;
            const bf16_t* kp = P + (size_t)(b * 2048 + (kb0 + kb) * 64 + key) * PC + C_KB + h * 64 + dc;
            k0 = *(const uint4*)kp; k1 = *(const uint4*)(kp + 8); v0 = *(const uint4*)(kp + 256); v1 = *(const uint4*)(kp + 264);
        } else if (kb < 8) {
            relbase = kb * 64 - 512;
            const size_t off = ((((size_t)l * 32 + b) * 4 + h) * 512 + kb * 64 + key) * 64 + dc;
            const float4* kp = (const float4*)(p.cache_k + off); const float4* vp = (const float4*)(p.cache_v + off);
            float4 a = kp[0], bb = kp[1], cc = kp[2], dd = kp[3];
            k0.x = pack2(a.x, a.y); k0.y = pack2(a.z, a.w); k0.z = pack2(bb.x, bb.y); k0.w = pack2(bb.z, bb.w);
            k1.x = pack2(cc.x, cc.y); k1.y = pack2(cc.z, cc.w); k1.z = pack2(dd.x, dd.y); k1.w = pack2(dd.z, dd.w);
            a = vp[0]; bb = vp[1]; cc = vp[2]; dd = vp[3];
            v0.x = pack2(a.x, a.y); v0.y = pack2(a.z, a.w); v0.z = pack2(bb.x, bb.y); v0.w = pack2(bb.z, bb.w);
            v1.x = pack2(cc.x, cc.y); v1.y = pack2(cc.z, cc.w); v1.z = pack2(dd.x, dd.y); v1.w = pack2(dd.z, dd.w);
        } else {
            relbase = 0; nvalid = 32;
            k0 = make_uint4(0, 0, 0, 0); k1 = k0; v0 = k0; v1 = k0;
            if (key < 32) {
                const bf16_t* kp = P + (size_t)(NPROMPT + b * 32 + key) * PC + C_KB + h * 64 + dc;
                k0 = *(const uint4*)kp; k1 = *(const uint4*)(kp + 8); v0 = *(const uint4*)(kp + 256); v1 = *(const uint4*)(kp + 264);
            }
        }
        __syncthreads();
        *(uint4*)(Ks + key * 72 + dc) = k0; *(uint4*)(Ks + key * 72 + dc + 8) = k1;
        {
            const unsigned vv[8] = {v0.x, v0.y, v0.z, v0.w, v1.x, v1.y, v1.z, v1.w};
#pragma unroll
            for (int j = 0; j < 8; ++j) { Vt[(dc + 2 * j) * 72 + key] = (bf16_t)(vv[j] & 0xffffu); Vt[(dc + 2 * j + 1) * 72 + key] = (bf16_t)(vv[j] >> 16); }
        }
        __syncthreads();
        if (act) {
            f32x4 s[4];
#pragma unroll
            for (int tt = 0; tt < 4; ++tt) {
                const bf16_t* kr = Ks + (tt * 16 + fr) * 72 + fq * 8;
                f32x4 z = (f32x4){0.f, 0.f, 0.f, 0.f};
                z = __builtin_amdgcn_mfma_f32_16x16x32_bf16(*(const bf16x8*)kr, qf0, z, 0, 0, 0);
                z = __builtin_amdgcn_mfma_f32_16x16x32_bf16(*(const bf16x8*)(kr + 32), qf1, z, 0, 0, 0);
                s[tt] = z;
            }
            float mb = -1e30f;
#pragma unroll
            for (int tt = 0; tt < 4; ++tt)
#pragma unroll
                for (int r = 0; r < 4; ++r) {
                    const int kj = tt * 16 + fq * 4 + r;
                    int rel = relbase + kj - qi; rel = rel < -256 ? -256 : (rel > 256 ? 256 : rel);
                    float sc = s[tt][r] * 0.125f + bias[rel + 256];
                    sc = (kj < nvalid) ? sc : -1e30f;
                    s[tt][r] = sc; mb = fmaxf(mb, sc);
                }
            mb = fmaxf(mb, __shfl_xor(mb, 16)); mb = fmaxf(mb, __shfl_xor(mb, 32));
            const float mn = fmaxf(m, mb), alpha = __expf(m - mn);
            m = mn;
            float ps = 0.f;
#pragma unroll
            for (int tt = 0; tt < 4; ++tt)
#pragma unroll
                for (int r = 0; r < 4; ++r) { const float pv = __expf(s[tt][r] - mn); s[tt][r] = pv; ps += pv; }
            lsum = lsum * alpha + ps;
#pragma unroll
            for (int dt = 0; dt < 4; ++dt) o[dt] *= alpha;
#pragma unroll
            for (int u = 0; u < 2; ++u) {
                union { bf16x8 v; unsigned q[4]; } pf;
                pf.q[0] = pack2(s[2 * u][0], s[2 * u][1]); pf.q[1] = pack2(s[2 * u][2], s[2 * u][3]);
                pf.q[2] = pack2(s[2 * u + 1][0], s[2 * u + 1][1]); pf.q[3] = pack2(s[2 * u + 1][2], s[2 * u + 1][3]);
#pragma unroll
                for (int dt = 0; dt < 4; ++dt) {
                    const bf16_t* vr = Vt + (dt * 16 + fr) * 72 + u * 32 + fq * 4;
                    union { bf16x8 v; uint2 q[2]; } vf;
                    vf.q[0] = *(const uint2*)vr; vf.q[1] = *(const uint2*)(vr + 16);
                    o[dt] = __builtin_amdgcn_mfma_f32_16x16x32_bf16(vf.v, pf.v, o[dt], 0, 0, 0);
                }
            }
        }
    }
    if (act) {
        lsum += __shfl_xor(lsum, 16); lsum += __shfl_xor(lsum, 32);
        const float inv = 1.f / lsum;
        bf16_t* op = mix + (size_t)(qrow0 + qi) * DM + 256 + h * 64 + fq * 4;
#pragma unroll
        for (int dt = 0; dt < 4; ++dt) { uint2 ov; ov.x = pack2(o[dt][0] * inv, o[dt][1] * inv); ov.y = pack2(o[dt][2] * inv, o[dt][3] * inv); *(uint2*)(op + dt * 16) = ov; }
    }
}

__device__ void delta_out(const Params& p, int l, int item, char* lds) {
    const Item it = decode_item(item);
    const int cs = it.cs, h = it.h, t = tid_opaque(), lane = t & 63, w = t >> 6, fr = lane & 15, fq = lane >> 4;
    bf16_t* Rl = (bf16_t*)lds;
    float* Sl = (float*)(lds + 8448);
    const bf16_t* gR = (const bf16_t*)(p.ws + OFF_REG + R_DR) + (size_t)item * 4096;
    const bf16_t* gO = (const bf16_t*)(p.ws + OFF_REG + R_DO0) + (size_t)item * 4096;
    const float* gS = (const float*)(p.ws + OFF_REG + R_DS) + (size_t)item * 4096;
    const bf16_t* P = (const bf16_t*)(p.ws + OFF_REG + R_P);
    bf16_t* mix = (bf16_t*)(p.ws + OFF_REG + R_MIX);
    __syncthreads();
    for (int e = t; e < cs * 64; e += 256) Rl[(e >> 6) * 66 + (e & 63)] = gR[e];
    for (int e = t; e < 4096; e += 256) Sl[(e >> 6) * 65 + (e & 63)] = gS[e];
    __syncthreads();
    if (w * 16 < cs) {
        f32x4 acc[4]; float ss[4] = {0.f, 0.f, 0.f, 0.f};
#pragma unroll
        for (int vt = 0; vt < 4; ++vt) {
#pragma unroll
            for (int r = 0; r < 4; ++r) acc[vt][r] = bf2f(gO[(w * 16 + fq * 4 + r) * 64 + vt * 16 + fr]);
            acc[vt] = mm16(Rl + w * 16 * 66, 66, 1, Sl + vt * 16, 65, 1, 64, acc[vt], lane);
#pragma unroll
            for (int r = 0; r < 4; ++r) ss[r] += acc[vt][r] * acc[vt][r];
        }
#pragma unroll
        for (int r = 0; r < 4; ++r) {
            float s = ss[r];
            s += __shfl_xor(s, 1); s += __shfl_xor(s, 2); s += __shfl_xor(s, 4); s += __shfl_xor(s, 8);
            const float rs = rsqrtf(s * (1.f / 64.f) + EPSV);
            const int row = it.row0 + w * 16 + fq * 4 + r;
#pragma unroll
            for (int vt = 0; vt < 4; ++vt) {
                const int v = vt * 16 + fr;
                const float z = bf2f(P[(size_t)row * PC + C_ZC + h * 64 + v]);
                mix[(size_t)row * DM + 512 + h * 64 + v] = f2bf(acc[vt][r] * rs * p.delta_norm_g[l * 64 + v] * siluf(z));
            }
        }
    }
}
__device__ void gla_out(const Params& p, int l, int item, char* lds) {
    const Item it = decode_item(item);
    const int cs = it.cs, h = it.h, t = tid_opaque(), lane = t & 63, w = t >> 6, fr = lane & 15, fq = lane >> 4;
    bf16_t* Ql = (bf16_t*)lds;
    float* Sl = (float*)(lds + 4352);
    const bf16_t* gQ = (const bf16_t*)(p.ws + OFF_REG + R_GQ) + (size_t)item * 2048;
    const bf16_t* gO = (const bf16_t*)(p.ws + OFF_REG + R_GO0) + (size_t)item * 4096;
    const float* gS = (const float*)(p.ws + OFF_REG + R_GS) + (size_t)item * 2048;
    const bf16_t* P = (const bf16_t*)(p.ws + OFF_REG + R_P);
    bf16_t* mix = (bf16_t*)(p.ws + OFF_REG + R_MIX);
    __syncthreads();
    for (int e = t; e < cs * 32; e += 256) Ql[(e >> 5) * 34 + (e & 31)] = gQ[e];
    for (int e = t; e < 2048; e += 256) Sl[(e >> 6) * 65 + (e & 63)] = gS[e];
    __syncthreads();
    if (w * 16 < cs) {
        f32x4 acc[4]; float ss[4] = {0.f, 0.f, 0.f, 0.f};
#pragma unroll
        for (int vt = 0; vt < 4; ++vt) {
#pragma unroll
            for (int r = 0; r < 4; ++r) acc[vt][r] = bf2f(gO[(w * 16 + fq * 4 + r) * 64 + vt * 16 + fr]);
            acc[vt] = mm16(Ql + w * 16 * 34, 34, 1, Sl + vt * 16, 65, 1, 32, acc[vt], lane);
#pragma unroll
            for (int r = 0; r < 4; ++r) ss[r] += acc[vt][r] * acc[vt][r];
        }
#pragma unroll
        for (int r = 0; r < 4; ++r) {
            float s = ss[r];
            s += __shfl_xor(s, 1); s += __shfl_xor(s, 2); s += __shfl_xor(s, 4); s += __shfl_xor(s, 8);
            const float rs = rsqrtf(s * (1.f / 64.f) + EPSV);
            const int row = it.row0 + w * 16 + fq * 4 + r;
#pragma unroll
            for (int vt = 0; vt < 4; ++vt) {
                const int v = vt * 16 + fr;
                const float z = bf2f(P[(size_t)row * PC + C_GD + h * 64 + v]);
                mix[(size_t)row * DM + 768 + h * 64 + v] = f2bf(acc[vt][r] * rs * p.gla_norm_g[l * 64 + v] * siluf(z));
            }
        }
    }
}

__device__ void pool_item(const Params& p, int l, int item, char* lds) {
    const int tile = item >> 2, g = item & 3, win = 2 << g;
    const int t = tid_opaque(), lane = t & 63, w = t >> 6, fr = lane & 15, fq = lane >> 4;
    float* Wl = (float*)lds;
    float* U = (float*)(lds + 16640);
    float* Pl = (float*)(lds + 28672);
    const bf16_t* P = (const bf16_t*)(p.ws + OFF_REG + R_P);
    bf16_t* mix = (bf16_t*)(p.ws + OFF_REG + R_MIX);
    int b, t0, row0; bool sample;
    if (tile < 512) { b = tile >> 6; t0 = (tile & 63) * 32; row0 = b * 2048 + t0; sample = false; }
    else { b = tile - 512; t0 = 0; row0 = NPROMPT + b * 32; sample = true; }
    __syncthreads();
    for (int e = t; e < 4096; e += 256) Wl[(e >> 6) * 65 + (e & 63)] = p.pool_w[((size_t)(l * 4 + g) * 64) * 64 + e];
    for (int e = t; e < 47 * 64; e += 256) {
        const int r = e >> 6, ch = e & 63, tt = r - 15;
        float v;
        if (t0 + tt >= 0) v = bf2f(P[(size_t)(row0 + tt) * PC + C_UA + g * 64 + ch]);
        else v = sample ? p.cache_pool[((size_t)(l * 32 + b) * 15 + (15 + tt)) * 256 + g * 64 + ch] : 0.f;
        U[e] = v;
    }
    __syncthreads();
    for (int e = t; e < 32 * 64; e += 256) {
        const int tt = e >> 6, ch = e & 63;
        float s = 0.f;
        for (int j = 0; j < win; ++j) s += U[(15 + tt - j) * 64 + ch];
        const int pos1 = t0 + tt + 1;
        const float cnt = (sample || pos1 > win) ? (float)win : (float)pos1;
        Pl[tt * 65 + ch] = s / cnt - U[(15 + tt) * 64 + ch];
    }
    __syncthreads();
#pragma unroll
    for (int mt = 0; mt < 2; ++mt) {
        f32x4 z = (f32x4){0.f, 0.f, 0.f, 0.f};
        f32x4 y = mm16(Pl + mt * 16 * 65, 65, 1, Wl + w * 16, 65, 1, 64, z, lane);
        const int d = g * 64 + w * 16 + fr;
        const float sc = p.pool_scale[l * 256 + d];
#pragma unroll
        for (int r = 0; r < 4; ++r) mix[(size_t)(row0 + mt * 16 + fq * 4 + r) * DM + d] = f2bf(y[r] * sc);
    }
}

__device__ void copy_outs(const Params& p, int l) {
    const bf16_t* P = (const bf16_t*)(p.ws + OFF_REG + R_P);
    const size_t gt = (size_t)blockIdx.x * 256 + tid_opaque(), gs = (size_t)gridDim.x * 256;
    for (size_t e = gt; e < 2 * 1048576; e += gs) {
        const int kv = (int)(e >> 20), r = (int)(e & 1048575), d = r & 63, j = (r >> 6) & 511, h = (r >> 15) & 3, b = r >> 17;
        p.out[(kv ? O_VP : O_KP) + (size_t)l * 1048576 + r] = bf2f(P[(size_t)(b * 2048 + 1536 + j) * PC + (kv ? C_VB : C_KB) + h * 64 + d]);
    }
    for (size_t e = gt; e < 2 * 262144; e += gs) {
        const int kv = (int)(e >> 18), r = (int)(e & 262143), d = r & 63, j = (r >> 6) & 31, h = (r >> 11) & 3, b = r >> 13;
        p.out[(kv ? O_VS : O_KS) + (size_t)l * 262144 + r] = bf2f(P[(size_t)(NPROMPT + b * 32 + j) * PC + (kv ? C_VB : C_KB) + h * 64 + d]);
    }
    for (size_t e = gt; e < 40 * 3840; e += gs) {
        const int bb = (int)(e / 3840), r = (int)(e % 3840), rr = r >> 8, ch = r & 255;
        if (bb < 8) p.out[O_POOLP + (size_t)l * 30720 + e] = bf2f(P[(size_t)(bb * 2048 + 2033 + rr) * PC + C_UA + ch]);
        else p.out[O_POOLS + (size_t)l * 122880 + (e - 30720)] = bf2f(P[(size_t)(NPROMPT + (bb - 8) * 32 + 17 + rr) * PC + C_UA + ch]);
    }
    for (size_t e = gt; e < 40 * 2304; e += gs) {
        const int bb = (int)(e / 2304), r = (int)(e % 2304), rr = r / 768, ch = r % 768;
        if (bb < 8) p.out[O_CONVP + (size_t)l * 18432 + e] = bf2f(P[(size_t)(bb * 2048 + 2045 + rr) * PC + C_QC + ch]);
        else p.out[O_CONVS + (size_t)l * 73728 + (e - 18432)] = bf2f(P[(size_t)(NPROMPT + (bb - 8) * 32 + 29 + rr) * PC + C_QC + ch]);
    }
}

__device__ void final_rows(const Params& p, int it) {
    const int w = tid_opaque() >> 6, lane = tid_opaque() & 63, row = it * 4 + w;
    const float* xres = (const float*)(p.ws + OFF_XRES) + (size_t)row * DM;
    const f32x4* pp = (const f32x4*)((const float*)(p.ws + OFF_SSQ) + (size_t)row * 16);
    const f32x4 pa = (pp[0] + pp[1]) + (pp[2] + pp[3]);
    const float rs = rsqrtf(((pa[0] + pa[1]) + (pa[2] + pa[3])) * (1.f / DM) + EPSV);
    float* y = p.out + (size_t)row * DM;
#pragma unroll
    for (int i = 0; i < 4; ++i) {
        const int c = lane * 4 + 256 * i;
        float4 v = *(const float4*)(xres + c); const float4 g = *(const float4*)(p.final_norm_g + c);
        v.x *= rs * g.x; v.y *= rs * g.y; v.z *= rs * g.z; v.w *= rs * g.w;
        *(float4*)(y + c) = v;
    }
}

__device__ void run_phase(const Params& p, int ph, char* lds) {
    const int G = gridDim.x, B = blockIdx.x;
    if (ph == 0) {
        for (int it = B; it < CV_TOTAL + NTOK / 4; it += G) {
            if (it < CV_TOTAL) convert_layer_item(p, 0, it, lds); else prologue_rows(p, it - CV_TOTAL);
        }
        return;
    }
    if (ph == 1 + 7 * DEPTH) { for (int it = B; it < NTOK / 4; it += G) final_rows(p, it); return; }
    const int l = (ph - 1) / 7, sp = (ph - 1) % 7;
    const bf16_t* wb = (const bf16_t*)(p.ws + ((l & 1) ? OFF_WB1 : OFF_WB0));
    float* ssq = (float*)(p.ws + OFF_SSQ);
    bf16_t* xb = (bf16_t*)(p.ws + OFF_XB);
    float* xres = (float*)(p.ws + OFF_XRES);
    EpiP e{};
    if (sp == 0) {
        e.obf = (bf16_t*)(p.ws + OFF_REG + R_P); e.ldo = PC; e.ssq_in = ssq;
        for (int it = B; it < 136 * 23; it += G) gemm_tile<0>(xb, DM, wb + WB_IN, DM, it / 23, it % 23, e, lds);
    } else if (sp == 1) {
        for (int it = B; it < 2 * NITEM; it += G) { if (it < NITEM) delta_prep(p, l, it, lds); else gla_prep(p, l, it - NITEM, lds); }
    } else if (sp == 2) {
        for (int it = B; it < 128 + 256 + NITEM + 512 + 1024; it += G) {
            int i = it;
            if (i < 128) delta_scan(p, l, i, lds);
            else if ((i -= 128) < 256) gla_scan(p, l, i);
            else if ((i -= 256) < NITEM) attn_item(p, l, i, lds);
            else if ((i -= NITEM) < 512) delta_scan(p, l, 128 + i, lds);
            else gla_scan(p, l, 256 + (i - 512));
        }
    } else if (sp == 3) {
        const int ncv = (l + 1 < DEPTH) ? CV_TOTAL : 0;
        for (int it = B; it < 2 * NITEM + 2176 + ncv; it += G) {
            int i = it;
            if (i < NITEM) delta_out(p, l, i, lds);
            else if ((i -= NITEM) < NITEM) gla_out(p, l, i, lds);
            else if ((i -= NITEM) < 2176) pool_item(p, l, i, lds);
            else convert_layer_item(p, l + 1, i - 2176, lds);
        }
        copy_outs(p, l);
    } else if (sp == 4) {
        e.xres = xres; e.xb = xb; e.ssq_out = ssq;
        for (int it = B; it < 136 * 8; it += G) gemm_tile<1>((const bf16_t*)(p.ws + OFF_REG + R_MIX), DM, wb + WB_OUT, DM, it / 8, it % 8, e, lds);
    } else if (sp == 5) {
        e.obf = (bf16_t*)(p.ws + OFF_REG); e.ldo = DFF; e.ssq_in = ssq;
        for (int it = B; it < 136 * 32; it += G) gemm_tile<2>(xb, DM, wb + WB_UP, DM, it / 32, it % 32, e, lds);
    } else {
        e.xres = xres; e.xb = xb; e.ssq_out = ssq;
        for (int it = B; it < 136 * 8; it += G) gemm_tile<1>((const bf16_t*)(p.ws + OFF_REG), DFF, wb + WB_DN, DFF, it / 8, it % 8, e, lds);
    }
}
constexpr int NPHASE = 2 + 7 * DEPTH;

__global__ void __launch_bounds__(256, 2) mega(Params p) {
    extern __shared__ __attribute__((aligned(16))) char lds[];
    for (int ph = p.ph_begin; ph < p.ph_end; ++ph) {
        run_phase(p, ph, lds);
        if (ph + 1 < p.ph_end) cg::this_grid().sync();
    }
}

extern "C" void kernel_launch(void* const* d_in, const int* in_sizes, int n_in, void* d_out, int out_size, void* d_ws, size_t ws_size, hipStream_t stream) {
    static int grid_blocks = 0;
    if (!grid_blocks) {
        int dev = 0, cus = 0, per_cu = 0;
        hipGetDevice(&dev);
        hipDeviceGetAttribute(&cus, hipDeviceAttributeMultiprocessorCount, dev);
        hipFuncSetAttribute((const void*)mega, hipFuncAttributeMaxDynamicSharedMemorySize, LDS_BYTES);
        hipOccupancyMaxActiveBlocksPerMultiprocessor(&per_cu, mega, 256, LDS_BYTES);
        if (per_cu < 1) per_cu = 1;
        grid_blocks = cus * per_cu;
    }
    if (ws_size < WS_NEED) { fprintf(stderr, "workspace too small: %zu < %zu\n", ws_size, (size_t)WS_NEED); return; }
    Params p{};
    const float** f = (const float**)&p;
    for (int i = 0; i < 25; ++i) f[i] = (const float*)d_in[i];
    p.out = (float*)d_out; p.ws = (char*)d_ws;
#if ONE_LAUNCH
    p.ph_begin = 0; p.ph_end = NPHASE;
    void* args[] = {&p};
    hipError_t e = hipLaunchCooperativeKernel((void*)mega, dim3(grid_blocks), dim3(256), args, LDS_BYTES, stream);
    if (e != hipSuccess) fprintf(stderr, "cooperative launch failed: %s (grid %d)\n", hipGetErrorString(e), grid_blocks);
#else
    for (int ph = 0; ph < NPHASE; ++ph) {
        p.ph_begin = ph; p.ph_end = ph + 1;
        hipLaunchKernelGGL(mega, dim3(grid_blocks), dim3(256), LDS_BYTES, stream, p);
    }
#endif
}
```

```cpp
#include <hip/hip_runtime.h>
#include <hip/hip_cooperative_groups.h>
#include <cstdio>
#include <cstdint>
namespace cg = cooperative_groups;

#ifndef ONE_LAUNCH
#define ONE_LAUNCH 1
#endif

typedef unsigned short bf16_t;
typedef short bf16x8 __attribute__((ext_vector_type(8)));
typedef float f32x4 __attribute__((ext_vector_type(4)));
typedef unsigned u32x4 __attribute__((ext_vector_type(4)));

constexpr int DM = 1024, NTOK = 17408, NPROMPT = 16384, PC = 2944, INC = 2840, DFF = 4096, DEPTH = 4;
constexpr int C_UA = 0, C_QB = 256, C_KB = 512, C_VB = 768, C_QC = 1024, C_ZC = 1792, C_AC = 2048, C_BC = 2052,
              C_QD = 2056, C_KD = 2184, C_VD = 2312, C_GD = 2568, C_GK = 2824;
constexpr int NITEM = 1152;
constexpr float EPSV = 1e-6f;
constexpr int LDS_BYTES = 77824;

constexpr size_t WB_IN = 0, WB_OUT = (size_t)PC * DM, WB_UP = WB_OUT + (size_t)DM * DM, WB_DN = WB_UP + (size_t)DFF * DM,
                 WB_ELEMS = WB_DN + (size_t)DM * DFF;
constexpr size_t OFF_WB0 = 0, OFF_WB1 = WB_ELEMS * 2, OFF_XRES = OFF_WB1 + WB_ELEMS * 2, OFF_XB = OFF_XRES + (size_t)NTOK * DM * 4,
                 OFF_SSQ = OFF_XB + (size_t)NTOK * DM * 2, OFF_REG = OFF_SSQ + (size_t)16 * NTOK * 4;
constexpr size_t R_P = 0, R_MIX = R_P + (size_t)NTOK * PC * 2, R_DM = R_MIX + (size_t)NTOK * DM * 2, R_DN = R_DM + (size_t)NITEM * 16384,
                 R_DR = R_DN + (size_t)NITEM * 16384, R_DO0 = R_DR + (size_t)NITEM * 8192, R_DS = R_DO0 + (size_t)NITEM * 8192,
                 R_GN = R_DS + (size_t)NITEM * 16384, R_GQ = R_GN + (size_t)NITEM * 8192, R_GO0 = R_GQ + (size_t)NITEM * 4096,
                 R_GD = R_GO0 + (size_t)NITEM * 8192, R_GS = R_GD + (size_t)NITEM * 128, R_END = R_GS + (size_t)NITEM * 8192;
constexpr size_t OFF_BAR = OFF_REG + R_END;
constexpr size_t WS_NEED = OFF_BAR + 16384;
static_assert((size_t)NTOK * DFF * 2 <= R_END, "up overlay");
constexpr size_t O_YP = 0, O_YS = 16777216, O_POOLP = O_YS + 1048576, O_KP = O_POOLP + 122880, O_VP = O_KP + 4194304, O_CONVP = O_VP + 4194304,
                 O_DELTAP = O_CONVP + 73728, O_GLAP = O_DELTAP + 524288, O_POOLS = O_GLAP + 262144, O_KS = O_POOLS + 491520, O_VS = O_KS + 1048576,
                 O_CONVS = O_VS + 1048576, O_DELTAS = O_CONVS + 294912, O_GLAS = O_DELTAS + 2097152;

struct Params {
    const float *x_prompt, *x_sample, *cache_pool, *cache_k, *cache_v, *state_conv, *state_delta, *state_gla;
    const float *attn_norm_g, *w_in, *pool_w, *pool_scale, *rel_bias, *conv_w, *a_log, *dt_bias, *delta_norm_g, *gla_w_gk, *gla_b_gk,
        *gla_norm_g, *w_out, *mlp_norm_g, *w_up, *w_down, *final_norm_g;
    float* out;
    char* ws;
    unsigned* bar;
    int ph_begin, ph_end, use_cg, pad0;
};

__device__ __forceinline__ float bf2f(bf16_t v) { return __uint_as_float(((unsigned)v) << 16); }
__device__ __forceinline__ bf16_t f2bf(float f) { unsigned u = __float_as_uint(f); u += 0x7fffu + ((u >> 16) & 1u); return (bf16_t)(u >> 16); }
__device__ __forceinline__ unsigned pack2(float lo, float hi) { return (unsigned)f2bf(lo) | ((unsigned)f2bf(hi) << 16); }
__device__ __forceinline__ float ldf(const float* p) { return *p; }
__device__ __forceinline__ float ldf(const bf16_t* p) { return bf2f(*p); }
__device__ __forceinline__ float wave_sum(float v) {
#pragma unroll
    for (int o = 32; o; o >>= 1) v += __shfl_xor(v, o);
    return v;
}
__device__ __forceinline__ float siluf(float x) { return x / (1.f + expf(-x)); }

template <typename TA, typename TB>
__device__ __forceinline__ f32x4 mm16(const TA* A, int a_rs, int a_cs, const TB* B, int b_rs, int b_cs, int K, f32x4 acc, int lane) {
    const int i = lane & 15, kq = lane >> 4;
    const TA* ap = A + i * a_rs + kq * a_cs;
    const TB* bp = B + kq * b_rs + i * b_cs;
    for (int k0 = 0; k0 < K; k0 += 4) {
        float a = ldf(ap + k0 * a_cs), b = ldf(bp + k0 * b_rs);
        acc = __builtin_amdgcn_mfma_f32_16x16x4f32(a, b, acc, 0, 0, 0);
    }
    return acc;
}

__device__ __forceinline__ int tid_opaque() { int t = threadIdx.x; asm volatile("" : "+v"(t)); return t; }
__device__ __forceinline__ const float* xin_row(const Params& p, int row) {
    return row < NPROMPT ? p.x_prompt + (size_t)row * DM : p.x_sample + (size_t)(row - NPROMPT) * DM;
}

__device__ void convert_tile(const float* __restrict__ src, bf16_t* __restrict__ dst, int K, int N, const float* __restrict__ g, int tile, char* lds) {
    float* T = (float*)lds;
    const int nkt = K >> 6, kt = tile % nkt, nt = tile / nkt, t = tid_opaque();
    __syncthreads();
#pragma unroll
    for (int i = 0; i < 4; ++i) {
        const int kl = (t >> 4) + 16 * i, k = kt * 64 + kl, nl = (t & 15) * 4, n0 = nt * 64 + nl;
        float4 v = make_float4(0.f, 0.f, 0.f, 0.f);
        if (n0 < N) v = *(const float4*)(src + (size_t)k * N + n0);
        if (g) { const float s = g[k]; v.x *= s; v.y *= s; v.z *= s; v.w *= s; }
        T[(nl + 0) * 65 + kl] = v.x; T[(nl + 1) * 65 + kl] = v.y; T[(nl + 2) * 65 + kl] = v.z; T[(nl + 3) * 65 + kl] = v.w;
    }
    __syncthreads();
    const int n = t >> 2, kc = (t & 3) * 16;
    const float* r = T + n * 65 + kc;
    uint4 a, b;
    a.x = pack2(r[0], r[1]); a.y = pack2(r[2], r[3]); a.z = pack2(r[4], r[5]); a.w = pack2(r[6], r[7]);
    b.x = pack2(r[8], r[9]); b.y = pack2(r[10], r[11]); b.z = pack2(r[12], r[13]); b.w = pack2(r[14], r[15]);
    bf16_t* d = dst + (size_t)(nt * 64 + n) * K + kt * 64 + kc;
    *(uint4*)d = a; *(uint4*)(d + 8) = b;
}
constexpr int CV_IN = 16 * 46, CV_OUT = 16 * 16, CV_UP = 16 * 64, CV_DN = 64 * 16, CV_TOTAL = CV_IN + CV_OUT + CV_UP + CV_DN;
__device__ void convert_layer_item(const Params& p, int l, int it, char* lds) {
    bf16_t* wb = (bf16_t*)(p.ws + ((l & 1) ? OFF_WB1 : OFF_WB0));
    if (it < CV_IN) convert_tile(p.w_in + (size_t)l * DM * INC, wb + WB_IN, DM, INC, p.attn_norm_g + l * DM, it, lds);
    else if ((it -= CV_IN) < CV_OUT) convert_tile(p.w_out + (size_t)l * DM * DM, wb + WB_OUT, DM, DM, nullptr, it, lds);
    else if ((it -= CV_OUT) < CV_UP) convert_tile(p.w_up + (size_t)l * DM * DFF, wb + WB_UP, DM, DFF, p.mlp_norm_g + l * DM, it, lds);
    else { it -= CV_UP; convert_tile(p.w_down + (size_t)l * DFF * DM, wb + WB_DN, DFF, DM, nullptr, it, lds); }
}

__device__ void prologue_rows(const Params& p, int it) {
    const int w = tid_opaque() >> 6, lane = tid_opaque() & 63, row = it * 4 + w;
    const float* x = xin_row(p, row);
    float* xres = (float*)(p.ws + OFF_XRES) + (size_t)row * DM;
    bf16_t* xb = (bf16_t*)(p.ws + OFF_XB) + (size_t)row * DM;
    float* ssq = (float*)(p.ws + OFF_SSQ);
    float s = 0.f;
#pragma unroll
    for (int i = 0; i < 4; ++i) {
        const int c = lane * 4 + 256 * i;
        float4 v = *(const float4*)(x + c);
        s += v.x * v.x + v.y * v.y + v.z * v.z + v.w * v.w;
        *(float4*)(xres + c) = v;
        uint2 o; o.x = pack2(v.x, v.y); o.y = pack2(v.z, v.w);
        *(uint2*)(xb + c) = o;
    }
    s = wave_sum(s);
    if (lane < 16) ssq[(size_t)row * 16 + lane] = lane == 0 ? s : 0.f;
}

struct EpiP { bf16_t* obf; int ldo; float* xres; bf16_t* xb; const float* ssq_in; float* ssq_out; };
constexpr int GLD = 72;
template <int EPI>
__device__ void gemm_tile(const bf16_t* __restrict__ A, int lda, const bf16_t* __restrict__ Bt, int K, int tm, int tn, const EpiP& e, char* lds) {
    const int t = tid_opaque(), lane = t & 63, w = t >> 6, wm = w >> 1, wn = w & 1, fr = lane & 15, fq = lane >> 4;
    const int lr = t >> 3, lc = (t & 7) * 8;
    const bf16_t* ag = A + (size_t)(tm * 128 + lr) * lda + lc;
    const bf16_t* bg = Bt + (size_t)(tn * 128 + lr) * K + lc;
    f32x4 acc[4][4];
#pragma unroll
    for (int i = 0; i < 4; ++i)
#pragma unroll
        for (int j = 0; j < 4; ++j) acc[i][j] = (f32x4){0.f, 0.f, 0.f, 0.f};
    u32x4 ra[4], rb[4];
#pragma unroll
    for (int i = 0; i < 4; ++i) { ra[i] = *(const u32x4*)(ag + (size_t)(32 * i) * lda); rb[i] = *(const u32x4*)(bg + (size_t)(32 * i) * K); }
    __syncthreads();
    {
        bf16_t* As = (bf16_t*)lds; bf16_t* Bs = As + 128 * GLD;
#pragma unroll
        for (int i = 0; i < 4; ++i) { *(u32x4*)(As + (lr + 32 * i) * GLD + lc) = ra[i]; *(u32x4*)(Bs + (lr + 32 * i) * GLD + lc) = rb[i]; }
    }
    __syncthreads();
    const int nk = K >> 6;
    for (int kt = 0; kt < nk; ++kt) {
        const bf16_t* As = (const bf16_t*)(lds + (kt & 1) * (256 * GLD * 2)); const bf16_t* Bs = As + 128 * GLD;
        if (kt + 1 < nk) {
#pragma unroll
            for (int i = 0; i < 4; ++i) { ra[i] = *(const u32x4*)(ag + (size_t)(32 * i) * lda + (kt + 1) * 64); rb[i] = *(const u32x4*)(bg + (size_t)(32 * i) * K + (kt + 1) * 64); }
        }
#pragma unroll
        for (int kh = 0; kh < 2; ++kh) {
            bf16x8 af[4], bfr[4];
#pragma unroll
            for (int i = 0; i < 4; ++i) {
                af[i] = *(const bf16x8*)(As + (wm * 64 + i * 16 + fr) * GLD + kh * 32 + fq * 8);
                bfr[i] = *(const bf16x8*)(Bs + (wn * 64 + i * 16 + fr) * GLD + kh * 32 + fq * 8);
            }
#pragma unroll
            for (int i = 0; i < 4; ++i)
#pragma unroll
                for (int j = 0; j < 4; ++j) acc[i][j] = __builtin_amdgcn_mfma_f32_16x16x32_bf16(bfr[j], af[i], acc[i][j], 0, 0, 0);
        }
        if (kt + 1 < nk) {
            bf16_t* An = (bf16_t*)(lds + ((kt + 1) & 1) * (256 * GLD * 2)); bf16_t* Bn = An + 128 * GLD;
#pragma unroll
            for (int i = 0; i < 4; ++i) { *(u32x4*)(An + (lr + 32 * i) * GLD + lc) = ra[i]; *(u32x4*)(Bn + (lr + 32 * i) * GLD + lc) = rb[i]; }
        }
        __syncthreads();
    }
#pragma unroll
    for (int i = 0; i < 4; ++i) {
        const int row = tm * 128 + wm * 64 + i * 16 + fr;
        float rs = 1.f;
        if (EPI == 0 || EPI == 2) {
            const f32x4* pp = (const f32x4*)(e.ssq_in + (size_t)row * 16);
            const f32x4 a = (pp[0] + pp[1]) + (pp[2] + pp[3]);
            rs = rsqrtf(((a[0] + a[1]) + (a[2] + a[3])) * (1.f / DM) + EPSV);
        }
        float sq = 0.f;
#pragma unroll
        for (int j = 0; j < 4; ++j) {
            const int col = tn * 128 + wn * 64 + j * 16 + fq * 4;
            f32x4 v = acc[i][j];
            if (EPI == 0) {
                uint2 o; o.x = pack2(v[0] * rs, v[1] * rs); o.y = pack2(v[2] * rs, v[3] * rs);
                *(uint2*)(e.obf + (size_t)row * e.ldo + col) = o;
            } else if (EPI == 2) {
                float a0 = fmaxf(v[0] * rs, 0.f), a1 = fmaxf(v[1] * rs, 0.f), a2 = fmaxf(v[2] * rs, 0.f), a3 = fmaxf(v[3] * rs, 0.f);
                uint2 o; o.x = pack2(a0 * a0, a1 * a1); o.y = pack2(a2 * a2, a3 * a3);
                *(uint2*)(e.obf + (size_t)row * e.ldo + col) = o;
            } else {
                float4 x = *(const float4*)(e.xres + (size_t)row * DM + col);
                x.x += v[0]; x.y += v[1]; x.z += v[2]; x.w += v[3];
                *(float4*)(e.xres + (size_t)row * DM + col) = x;
                uint2 o; o.x = pack2(x.x, x.y); o.y = pack2(x.z, x.w);
                *(uint2*)(e.xb + (size_t)row * DM + col) = o;
                sq += x.x * x.x + x.y * x.y + x.z * x.z + x.w * x.w;
            }
        }
        if (EPI == 1) {
            sq += __shfl_xor(sq, 16); sq += __shfl_xor(sq, 32);
            if (fq == 0) e.ssq_out[(size_t)row * 16 + tn * 2 + wn] = sq;
        }
    }
}

struct Item { int b, h, c, cs, row0; bool sample; };
__device__ __forceinline__ Item decode_item(int item) {
    Item r;
    if (item < 1024) { r.b = item >> 7; r.h = (item >> 5) & 3; r.c = item & 31; r.cs = 64; r.row0 = r.b * 2048 + r.c * 64; r.sample = false; }
    else { const int s = item - 1024; r.b = s >> 2; r.h = s & 3; r.c = 0; r.cs = 32; r.row0 = NPROMPT + r.b * 32; r.sample = true; }
    return r;
}

__device__ void delta_prep(const Params& p, int l, int item, char* lds) {
    const Item it = decode_item(item);
    const int cs = it.cs, h = it.h, t = tid_opaque(), lane = t & 63, w = t >> 6, fr = lane & 15, fq = lane >> 4;
    float* Ks = (float*)lds;
    float* X = (float*)(lds + 16640);
    float* Am = (float*)(lds + 49664);
    bf16_t* QKm = (bf16_t*)(lds + 66304);
    float* Gs = (float*)(lds + 74752);
    float* Bs = (float*)(lds + 75008);
    const bf16_t* P = (const bf16_t*)(p.ws + OFF_REG + R_P);
    const float* cw = p.conv_w + (size_t)l * 4 * 768;
    const float* hist = p.state_conv + (size_t)(l * 32 + it.b) * 3 * 768;
    __syncthreads();
    for (int e = t; e < cs * 192; e += 256) {
        const int tok = e / 192, ch = e - tok * 192, which = ch >> 6, d = ch & 63, cwi = which * 256 + h * 64 + d, col = C_QC + cwi;
        float acc = 0.f;
#pragma unroll
        for (int j = 0; j < 4; ++j) {
            const int tt = tok - 3 + j;
            float xv;
            if (tt >= 0) xv = bf2f(P[(size_t)(it.row0 + tt) * PC + col]);
            else if (it.sample) xv = hist[(3 + tt) * 768 + cwi];
            else xv = (it.c > 0) ? bf2f(P[(size_t)(it.row0 + tt) * PC + col]) : 0.f;
            acc += xv * cw[j * 768 + cwi];
        }
        const float cv = siluf(acc);
        if (which == 0) X[tok * 129 + 64 + d] = cv; else if (which == 1) Ks[tok * 65 + d] = cv; else X[tok * 129 + d] = cv;
    }
    __syncthreads();
    for (int tok = w; tok < cs; tok += 4) {
        const float kv = Ks[tok * 65 + lane], qv = X[tok * 129 + 64 + lane];
        const float sk = wave_sum(kv * kv), sq = wave_sum(qv * qv);
        Ks[tok * 65 + lane] = kv * rsqrtf(sk + EPSV);
        X[tok * 129 + 64 + lane] = qv * rsqrtf(sq + EPSV) * 0.125f;
    }
    if (t < cs) {
        const float a = bf2f(P[(size_t)(it.row0 + t) * PC + C_AC + h]), bb = bf2f(P[(size_t)(it.row0 + t) * PC + C_BC + h]);
        const float xs = a + p.dt_bias[l * 4 + h];
        const float sp = xs > 20.f ? xs : log1pf(expf(xs));
        Gs[t] = -expf(p.a_log[l * 4 + h]) * sp;
        Bs[t] = 1.f / (1.f + expf(-bb));
    }
    __syncthreads();
    if (w == 0) {
        float v = lane < cs ? Gs[lane] : 0.f;
#pragma unroll
        for (int o = 1; o < 64; o <<= 1) { const float n = __shfl_up(v, o); if (lane >= o) v += n; }
        if (lane < cs) Gs[lane] = v;
    }
    __syncthreads();
    const bool act = (w * 16 < cs);
    f32x4 qreg[4];
    if (act) {
        f32x4 aK[4], aQ[4];
#pragma unroll
        for (int jt = 0; jt < 4; ++jt) {
            aK[jt] = (f32x4){0.f, 0.f, 0.f, 0.f}; aQ[jt] = aK[jt];
            if (jt * 16 < cs) {
                aK[jt] = mm16(Ks + w * 16 * 65, 65, 1, Ks + jt * 16 * 65, 1, 65, 64, aK[jt], lane);
                aQ[jt] = mm16(X + w * 16 * 129 + 64, 129, 1, Ks + jt * 16 * 65, 1, 65, 64, aQ[jt], lane);
            }
        }
#pragma unroll
        for (int nt = 0; nt < 4; ++nt)
#pragma unroll
            for (int r = 0; r < 4; ++r) { const int i = w * 16 + fq * 4 + r; qreg[nt][r] = X[i * 129 + 64 + nt * 16 + fr] * expf(Gs[i]); }
#pragma unroll
        for (int jt = 0; jt < 4; ++jt)
            if (jt * 16 < cs) {
#pragma unroll
                for (int r = 0; r < 4; ++r) {
                    const int i = w * 16 + fq * 4 + r, j = jt * 16 + fr;
                    const float dec = (j <= i) ? expf(Gs[i] - Gs[j]) : 0.f;
                    Am[i * 65 + j] = (j < i) ? Bs[i] * aK[jt][r] * dec : 0.f;
                    QKm[i * 66 + j] = f2bf(aQ[jt][r] * dec);
                }
            }
    }
    __syncthreads();
    for (int e = t; e < cs * 64; e += 256) {
        const int i = e >> 6, d = e & 63;
        const float b = Bs[i];
        X[i * 129 + 64 + d] = b * expf(Gs[i]) * Ks[i * 65 + d];
        X[i * 129 + d] *= b;
    }
    __syncthreads();
    if (t < 128) {
        for (int i = 1; i < cs; ++i) {
            float s = X[i * 129 + t];
            const float* ar = Am + i * 65;
            for (int j = 0; j < i; ++j) s -= ar[j] * X[j * 129 + t];
            X[i * 129 + t] = s;
        }
    }
    __syncthreads();
    const float gl = Gs[cs - 1];
    for (int e = t; e < cs * 64; e += 256) { const int i = e >> 6, d = e & 63; Ks[i * 65 + d] *= expf(gl - Gs[i]); }
    __syncthreads();
    float* oM = (float*)(p.ws + OFF_REG + R_DM) + (size_t)item * 4096;
    float* oN = (float*)(p.ws + OFF_REG + R_DN) + (size_t)item * 4096;
    bf16_t* oR = (bf16_t*)(p.ws + OFF_REG + R_DR) + (size_t)item * 4096;
    bf16_t* oO = (bf16_t*)(p.ws + OFF_REG + R_DO0) + (size_t)item * 4096;
    const float egl = expf(gl);
#pragma unroll
    for (int bt = 0; bt < 4; ++bt) {
        f32x4 z = (f32x4){0.f, 0.f, 0.f, 0.f};
        f32x4 cm = mm16(Ks + w * 16, 1, 65, X + 64 + bt * 16, 129, 1, cs, z, lane);
        f32x4 cn = mm16(Ks + w * 16, 1, 65, X + bt * 16, 129, 1, cs, z, lane);
#pragma unroll
        for (int r = 0; r < 4; ++r) {
            const int a = w * 16 + fq * 4 + r, b = bt * 16 + fr;
            oM[a * 64 + b] = ((a == b) ? egl : 0.f) - cm[r];
            oN[a * 64 + b] = cn[r];
        }
    }
    if (act) {
#pragma unroll
        for (int bt = 0; bt < 4; ++bt) {
            f32x4 z = (f32x4){0.f, 0.f, 0.f, 0.f};
            f32x4 cr = mm16(QKm + w * 16 * 66, 66, 1, X + 64 + bt * 16, 129, 1, cs, z, lane);
            f32x4 co = mm16(QKm + w * 16 * 66, 66, 1, X + bt * 16, 129, 1, cs, z, lane);
#pragma unroll
            for (int r = 0; r < 4; ++r) {
                const int i = w * 16 + fq * 4 + r, b = bt * 16 + fr;
                oR[i * 64 + b] = f2bf(qreg[bt][r] - cr[r]);
                oO[i * 64 + b] = f2bf(co[r]);
            }
        }
    }
}

__device__ void gla_prep(const Params& p, int l, int item, char* lds) {
    const Item it = decode_item(item);
    const int cs = it.cs, h = it.h, t = tid_opaque(), lane = t & 63, w = t >> 6, fr = lane & 15, fq = lane >> 4;
    float* Qg = (float*)lds;
    float* Kn = (float*)(lds + 8448);
    float* Kd = (float*)(lds + 16896);
    float* Gs = (float*)(lds + 25344);
    float* Vs = (float*)(lds + 33792);
    float* Att = (float*)(lds + 50432);
    const bf16_t* P = (const bf16_t*)(p.ws + OFF_REG + R_P);
    __syncthreads();
    for (int e = t; e < cs * 32; e += 256) {
        const int tok = e >> 5, kk = e & 31;
        const bf16_t* pr = P + (size_t)(it.row0 + tok) * PC;
        Qg[tok * 33 + kk] = bf2f(pr[C_QD + h * 32 + kk]);
        Kn[tok * 33 + kk] = bf2f(pr[C_KD + h * 32 + kk]);
        float x = p.gla_b_gk[l * 128 + h * 32 + kk];
#pragma unroll
        for (int r = 0; r < 16; ++r) x += bf2f(pr[C_GK + r]) * p.gla_w_gk[(size_t)(l * 16 + r) * 128 + h * 32 + kk];
        const float ls = fminf(x, 0.f) - log1pf(expf(-fabsf(x)));
        Gs[tok * 33 + kk] = ls * (1.f / 16.f);
    }
    for (int e = t; e < cs * 64; e += 256) {
        const int tok = e >> 6, d = e & 63;
        Vs[tok * 65 + d] = bf2f(P[(size_t)(it.row0 + tok) * PC + C_VD + h * 64 + d]);
    }
    __syncthreads();
    if (t < 32) { float s = 0.f; for (int tok = 0; tok < cs; ++tok) { s += Gs[tok * 33 + t]; Gs[tok * 33 + t] = s; } }
    __syncthreads();
    bf16_t* oQ = (bf16_t*)(p.ws + OFF_REG + R_GQ) + (size_t)item * 2048;
    for (int e = t; e < cs * 32; e += 256) {
        const int tok = e >> 5, kk = e & 31;
        const float G = Gs[tok * 33 + kk], gl = Gs[(cs - 1) * 33 + kk], q = Qg[tok * 33 + kk], k = Kn[tok * 33 + kk];
        const float qg = q * 0.17677669529663687f * expf(G);
        Qg[tok * 33 + kk] = qg; Kn[tok * 33 + kk] = k * expf(-G); Kd[tok * 33 + kk] = k * expf(gl - G);
        oQ[tok * 32 + kk] = f2bf(qg);
    }
    if (t < 32) ((float*)(p.ws + OFF_REG + R_GD))[(size_t)item * 32 + t] = expf(Gs[(cs - 1) * 33 + t]);
    __syncthreads();
    const bool act = (w * 16 < cs);
    if (act) {
#pragma unroll
        for (int jt = 0; jt < 4; ++jt)
            if (jt * 16 < cs) {
                f32x4 z = (f32x4){0.f, 0.f, 0.f, 0.f};
                f32x4 a = mm16(Qg + w * 16 * 33, 33, 1, Kn + jt * 16 * 33, 1, 33, 32, z, lane);
#pragma unroll
                for (int r = 0; r < 4; ++r) { const int i = w * 16 + fq * 4 + r, j = jt * 16 + fr; Att[i * 65 + j] = (j <= i) ? a[r] : 0.f; }
            }
    }
    float* oN = (float*)(p.ws + OFF_REG + R_GN) + (size_t)item * 2048;
#pragma unroll
    for (int q2 = 0; q2 < 2; ++q2) {
        const int tile = w + 4 * q2, at = tile >> 2, vt = tile & 3;
        f32x4 z = (f32x4){0.f, 0.f, 0.f, 0.f};
        f32x4 cn = mm16(Kd + at * 16, 1, 33, Vs + vt * 16, 65, 1, cs, z, lane);
#pragma unroll
        for (int r = 0; r < 4; ++r) oN[(at * 16 + fq * 4 + r) * 64 + vt * 16 + fr] = cn[r];
    }
    __syncthreads();
    if (act) {
        bf16_t* oO = (bf16_t*)(p.ws + OFF_REG + R_GO0) + (size_t)item * 4096;
#pragma unroll
        for (int vt = 0; vt < 4; ++vt) {
            f32x4 z = (f32x4){0.f, 0.f, 0.f, 0.f};
            f32x4 co = mm16(Att + w * 16 * 65, 65, 1, Vs + vt * 16, 65, 1, cs, z, lane);
#pragma unroll
            for (int r = 0; r < 4; ++r) oO[(w * 16 + fq * 4 + r) * 64 + vt * 16 + fr] = f2bf(co[r]);
        }
    }
}

__device__ void delta_scan(const Params& p, int l, int idx, char* lds) {
    const int t = tid_opaque(), lane = t & 63, w = t >> 6, fr = lane & 15, fq = lane >> 4;
    float* Sl = (float*)lds;
    int item0, nsteps, v0; float* outp; const float* s0 = nullptr;
    if (idx < 128) { const int bh = idx >> 2; v0 = (idx & 3) * 16; item0 = bh * 32; nsteps = 32; outp = p.out + O_DELTAP + ((size_t)l * 32 + bh) * 4096; }
    else { const int s = idx - 128, bh = s >> 2; v0 = (s & 3) * 16; item0 = 1024 + bh; nsteps = 1; outp = p.out + O_DELTAS + ((size_t)l * 128 + bh) * 4096;
           s0 = p.state_delta + ((size_t)l * 128 + bh) * 4096; }
    const float* gM = (const float*)(p.ws + OFF_REG + R_DM);
    const float* gN = (const float*)(p.ws + OFF_REG + R_DN);
    float* gS = (float*)(p.ws + OFF_REG + R_DS);
    f32x4 sreg;
#pragma unroll
    for (int r = 0; r < 4; ++r) sreg[r] = s0 ? s0[(w * 16 + fq * 4 + r) * 64 + v0 + fr] : 0.f;
    __syncthreads();
#pragma unroll
    for (int r = 0; r < 4; ++r) Sl[(w * 16 + fq * 4 + r) * 17 + fr] = sreg[r];
    __syncthreads();
    for (int c = 0; c < nsteps; ++c) {
        const size_t ib = (size_t)(item0 + c) * 4096;
        float aM[16];
#pragma unroll
        for (int kk = 0; kk < 16; ++kk) aM[kk] = gM[ib + (w * 16 + fr) * 64 + kk * 4 + fq];
        f32x4 acc;
#pragma unroll
        for (int r = 0; r < 4; ++r) { const int a = w * 16 + fq * 4 + r; acc[r] = gN[ib + a * 64 + v0 + fr]; gS[ib + a * 64 + v0 + fr] = sreg[r]; }
#pragma unroll
        for (int kk = 0; kk < 16; ++kk) acc = __builtin_amdgcn_mfma_f32_16x16x4f32(aM[kk], Sl[(kk * 4 + fq) * 17 + fr], acc, 0, 0, 0);
        __syncthreads();
        sreg = acc;
#pragma unroll
        for (int r = 0; r < 4; ++r) Sl[(w * 16 + fq * 4 + r) * 17 + fr] = sreg[r];
        __syncthreads();
    }
#pragma unroll
    for (int r = 0; r < 4; ++r) outp[(w * 16 + fq * 4 + r) * 64 + v0 + fr] = sreg[r];
}

__device__ void gla_scan(const Params& p, int l, int idx) {
    const int t = tid_opaque();
    int item0, nsteps, e; float* outp; float S = 0.f;
    if (idx < 256) { const int bh = idx >> 3; e = (idx & 7) * 256 + t; item0 = bh * 32; nsteps = 32; outp = p.out + O_GLAP + ((size_t)l * 32 + bh) * 2048; }
    else { const int s = idx - 256, bh = s >> 3; e = (s & 7) * 256 + t; item0 = 1024 + bh; nsteps = 1; outp = p.out + O_GLAS + ((size_t)l * 128 + bh) * 2048;
           S = p.state_gla[((size_t)l * 128 + bh) * 2048 + e]; }
    const float* gN = (const float*)(p.ws + OFF_REG + R_GN);
    const float* gD = (const float*)(p.ws + OFF_REG + R_GD);
    float* gS = (float*)(p.ws + OFF_REG + R_GS);
    const int a = e >> 6;
    for (int c = 0; c < nsteps; ++c) {
        const size_t ib = (size_t)(item0 + c);
        gS[ib * 2048 + e] = S;
        S = gD[ib * 32 + a] * S + gN[ib * 2048 + e];
    }
    outp[e] = S;
}

__device__ void attn_item(const Params& p, int l, int item, char* lds) {
    bf16_t* Ks = (bf16_t*)lds;
    bf16_t* Vt = (bf16_t*)(lds + 9216);
    float* bias = (float*)(lds + 18432);
    const bf16_t* P = (const bf16_t*)(p.ws + OFF_REG + R_P);
    bf16_t* mix = (bf16_t*)(p.ws + OFF_REG + R_MIX);
    const int t = tid_opaque(), lane = t & 63, w = t >> 6, fr = lane & 15, fq = lane >> 4;
    int b, h, c = 0, nq, qrow0, nkb, kb0 = 0; bool sample;
    if (item < 1024) { b = item >> 7; c = (item >> 2) & 31; h = item & 3; nq = 64; qrow0 = b * 2048 + c * 64; kb0 = c > 8 ? c - 8 : 0; nkb = c - kb0 + 1; sample = false; }
    else { const int s = item - 1024; b = s >> 2; h = s & 3; nq = 32; qrow0 = NPROMPT + b * 32; nkb = 9; sample = true; }
    __syncthreads();
    for (int i = t; i < 513; i += 256) bias[i] = p.rel_bias[(size_t)(l * 4 + h) * 513 + i];
    const bool act = (w * 16 < nq);
    bf16x8 qf0 = {0, 0, 0, 0, 0, 0, 0, 0}, qf1 = qf0;
    if (act) { const bf16_t* qp = P + (size_t)(qrow0 + w * 16 + fr) * PC + C_QB + h * 64 + fq * 8; qf0 = *(const bf16x8*)qp; qf1 = *(const bf16x8*)(qp + 32); }
    float m = -1e30f, lsum = 0.f;
    f32x4 o[4];
#pragma unroll
    for (int i = 0; i < 4; ++i) o[i] = (f32x4){0.f, 0.f, 0.f, 0.f};
    const int qi = w * 16 + fr;
    const int key = t >> 2, dc = (t & 3) * 16;
    for (int kb = 0; kb < nkb; ++kb) {
        int nvalid = 64, relbase;
        uint4 k0, k1, v0, v1;
        if (!sample) {
            relbase = (kb0 + kb - c) * 64;
            const bf16_t* kp = P + (size_t)(b * 2048 + (kb0 + kb) * 64 + key) * PC + C_KB + h * 64 + dc;
            k0 = *(const uint4*)kp; k1 = *(const uint4*)(kp + 8); v0 = *(const uint4*)(kp + 256); v1 = *(const uint4*)(kp + 264);
        } else if (kb < 8) {
            relbase = kb * 64 - 512;
            const size_t off = ((((size_t)l * 32 + b) * 4 + h) * 512 + kb * 64 + key) * 64 + dc;
            const float4* kp = (const float4*)(p.cache_k + off); const float4* vp = (const float4*)(p.cache_v + off);
            float4 a = kp[0], bb = kp[1], cc = kp[2], dd = kp[3];
            k0.x = pack2(a.x, a.y); k0.y = pack2(a.z, a.w); k0.z = pack2(bb.x, bb.y); k0.w = pack2(bb.z, bb.w);
            k1.x = pack2(cc.x, cc.y); k1.y = pack2(cc.z, cc.w); k1.z = pack2(dd.x, dd.y); k1.w = pack2(dd.z, dd.w);
            a = vp[0]; bb = vp[1]; cc = vp[2]; dd = vp[3];
            v0.x = pack2(a.x, a.y); v0.y = pack2(a.z, a.w); v0.z = pack2(bb.x, bb.y); v0.w = pack2(bb.z, bb.w);
            v1.x = pack2(cc.x, cc.y); v1.y = pack2(cc.z, cc.w); v1.z = pack2(dd.x, dd.y); v1.w = pack2(dd.z, dd.w);
        } else {
            relbase = 0; nvalid = 32;
            k0 = make_uint4(0, 0, 0, 0); k1 = k0; v0 = k0; v1 = k0;
            if (key < 32) {
                const bf16_t* kp = P + (size_t)(NPROMPT + b * 32 + key) * PC + C_KB + h * 64 + dc;
                k0 = *(const uint4*)kp; k1 = *(const uint4*)(kp + 8); v0 = *(const uint4*)(kp + 256); v1 = *(const uint4*)(kp + 264);
            }
        }
        __syncthreads();
        *(uint4*)(Ks + key * 72 + dc) = k0; *(uint4*)(Ks + key * 72 + dc + 8) = k1;
        {
            const unsigned vv[8] = {v0.x, v0.y, v0.z, v0.w, v1.x, v1.y, v1.z, v1.w};
#pragma unroll
            for (int j = 0; j < 8; ++j) { Vt[(dc + 2 * j) * 72 + key] = (bf16_t)(vv[j] & 0xffffu); Vt[(dc + 2 * j + 1) * 72 + key] = (bf16_t)(vv[j] >> 16); }
        }
        __syncthreads();
        if (act) {
            f32x4 s[4];
#pragma unroll
            for (int tt = 0; tt < 4; ++tt) {
                const bf16_t* kr = Ks + (tt * 16 + fr) * 72 + fq * 8;
                f32x4 z = (f32x4){0.f, 0.f, 0.f, 0.f};
                z = __builtin_amdgcn_mfma_f32_16x16x32_bf16(*(const bf16x8*)kr, qf0, z, 0, 0, 0);
                z = __builtin_amdgcn_mfma_f32_16x16x32_bf16(*(const bf16x8*)(kr + 32), qf1, z, 0, 0, 0);
                s[tt] = z;
            }
            float mb = -1e30f;
#pragma unroll
            for (int tt = 0; tt < 4; ++tt)
#pragma unroll
                for (int r = 0; r < 4; ++r) {
                    const int kj = tt * 16 + fq * 4 + r;
                    int rel = relbase + kj - qi; rel = rel < -256 ? -256 : (rel > 256 ? 256 : rel);
                    float sc = s[tt][r] * 0.125f + bias[rel + 256];
                    sc = (kj < nvalid) ? sc : -1e30f;
                    s[tt][r] = sc; mb = fmaxf(mb, sc);
                }
            mb = fmaxf(mb, __shfl_xor(mb, 16)); mb = fmaxf(mb, __shfl_xor(mb, 32));
            const float mn = fmaxf(m, mb), alpha = __expf(m - mn);
            m = mn;
            float ps = 0.f;
#pragma unroll
            for (int tt = 0; tt < 4; ++tt)
#pragma unroll
                for (int r = 0; r < 4; ++r) { const float pv = __expf(s[tt][r] - mn); s[tt][r] = pv; ps += pv; }
            lsum = lsum * alpha + ps;
#pragma unroll
            for (int dt = 0; dt < 4; ++dt) o[dt] *= alpha;
#pragma unroll
            for (int u = 0; u < 2; ++u) {
                union { bf16x8 v; unsigned q[4]; } pf;
                pf.q[0] = pack2(s[2 * u][0], s[2 * u][1]); pf.q[1] = pack2(s[2 * u][2], s[2 * u][3]);
                pf.q[2] = pack2(s[2 * u + 1][0], s[2 * u + 1][1]); pf.q[3] = pack2(s[2 * u + 1][2], s[2 * u + 1][3]);
#pragma unroll
                for (int dt = 0; dt < 4; ++dt) {
                    const bf16_t* vr = Vt + (dt * 16 + fr) * 72 + u * 32 + fq * 4;
                    union { bf16x8 v; uint2 q[2]; } vf;
                    vf.q[0] = *(const uint2*)vr; vf.q[1] = *(const uint2*)(vr + 16);
                    o[dt] = __builtin_amdgcn_mfma_f32_16x16x32_bf16(vf.v, pf.v, o[dt], 0, 0, 0);
                }
            }
        }
    }
    if (act) {
        lsum += __shfl_xor(lsum, 16); lsum += __shfl_xor(lsum, 32);
        const float inv = 1.f / lsum;
        bf16_t* op = mix + (size_t)(qrow0 + qi) * DM + 256 + h * 64 + fq * 4;
#pragma unroll
        for (int dt = 0; dt < 4; ++dt) { uint2 ov; ov.x = pack2(o[dt][0] * inv, o[dt][1] * inv); ov.y = pack2(o[dt][2] * inv, o[dt][3] * inv); *(uint2*)(op + dt * 16) = ov; }
    }
}

__device__ void delta_out(const Params& p, int l, int item, char* lds) {
    const Item it = decode_item(item);
    const int cs = it.cs, h = it.h, t = tid_opaque(), lane = t & 63, w = t >> 6, fr = lane & 15, fq = lane >> 4;
    bf16_t* Rl = (bf16_t*)lds;
    float* Sl = (float*)(lds + 8448);
    const bf16_t* gR = (const bf16_t*)(p.ws + OFF_REG + R_DR) + (size_t)item * 4096;
    const bf16_t* gO = (const bf16_t*)(p.ws + OFF_REG + R_DO0) + (size_t)item * 4096;
    const float* gS = (const float*)(p.ws + OFF_REG + R_DS) + (size_t)item * 4096;
    const bf16_t* P = (const bf16_t*)(p.ws + OFF_REG + R_P);
    bf16_t* mix = (bf16_t*)(p.ws + OFF_REG + R_MIX);
    __syncthreads();
    for (int e = t; e < cs * 64; e += 256) Rl[(e >> 6) * 66 + (e & 63)] = gR[e];
    for (int e = t; e < 4096; e += 256) Sl[(e >> 6) * 65 + (e & 63)] = gS[e];
    __syncthreads();
    if (w * 16 < cs) {
        f32x4 acc[4]; float ss[4] = {0.f, 0.f, 0.f, 0.f};
#pragma unroll
        for (int vt = 0; vt < 4; ++vt) {
#pragma unroll
            for (int r = 0; r < 4; ++r) acc[vt][r] = bf2f(gO[(w * 16 + fq * 4 + r) * 64 + vt * 16 + fr]);
            acc[vt] = mm16(Rl + w * 16 * 66, 66, 1, Sl + vt * 16, 65, 1, 64, acc[vt], lane);
#pragma unroll
            for (int r = 0; r < 4; ++r) ss[r] += acc[vt][r] * acc[vt][r];
        }
#pragma unroll
        for (int r = 0; r < 4; ++r) {
            float s = ss[r];
            s += __shfl_xor(s, 1); s += __shfl_xor(s, 2); s += __shfl_xor(s, 4); s += __shfl_xor(s, 8);
            const float rs = rsqrtf(s * (1.f / 64.f) + EPSV);
            const int row = it.row0 + w * 16 + fq * 4 + r;
#pragma unroll
            for (int vt = 0; vt < 4; ++vt) {
                const int v = vt * 16 + fr;
                const float z = bf2f(P[(size_t)row * PC + C_ZC + h * 64 + v]);
                mix[(size_t)row * DM + 512 + h * 64 + v] = f2bf(acc[vt][r] * rs * p.delta_norm_g[l * 64 + v] * siluf(z));
            }
        }
    }
}
__device__ void gla_out(const Params& p, int l, int item, char* lds) {
    const Item it = decode_item(item);
    const int cs = it.cs, h = it.h, t = tid_opaque(), lane = t & 63, w = t >> 6, fr = lane & 15, fq = lane >> 4;
    bf16_t* Ql = (bf16_t*)lds;
    float* Sl = (float*)(lds + 4352);
    const bf16_t* gQ = (const bf16_t*)(p.ws + OFF_REG + R_GQ) + (size_t)item * 2048;
    const bf16_t* gO = (const bf16_t*)(p.ws + OFF_REG + R_GO0) + (size_t)item * 4096;
    const float* gS = (const float*)(p.ws + OFF_REG + R_GS) + (size_t)item * 2048;
    const bf16_t* P = (const bf16_t*)(p.ws + OFF_REG + R_P);
    bf16_t* mix = (bf16_t*)(p.ws + OFF_REG + R_MIX);
    __syncthreads();
    for (int e = t; e < cs * 32; e += 256) Ql[(e >> 5) * 34 + (e & 31)] = gQ[e];
    for (int e = t; e < 2048; e += 256) Sl[(e >> 6) * 65 + (e & 63)] = gS[e];
    __syncthreads();
    if (w * 16 < cs) {
        f32x4 acc[4]; float ss[4] = {0.f, 0.f, 0.f, 0.f};
#pragma unroll
        for (int vt = 0; vt < 4; ++vt) {
#pragma unroll
            for (int r = 0; r < 4; ++r) acc[vt][r] = bf2f(gO[(w * 16 + fq * 4 + r) * 64 + vt * 16 + fr]);
            acc[vt] = mm16(Ql + w * 16 * 34, 34, 1, Sl + vt * 16, 65, 1, 32, acc[vt], lane);
#pragma unroll
            for (int r = 0; r < 4; ++r) ss[r] += acc[vt][r] * acc[vt][r];
        }
#pragma unroll
        for (int r = 0; r < 4; ++r) {
            float s = ss[r];
            s += __shfl_xor(s, 1); s += __shfl_xor(s, 2); s += __shfl_xor(s, 4); s += __shfl_xor(s, 8);
            const float rs = rsqrtf(s * (1.f / 64.f) + EPSV);
            const int row = it.row0 + w * 16 + fq * 4 + r;
#pragma unroll
            for (int vt = 0; vt < 4; ++vt) {
                const int v = vt * 16 + fr;
                const float z = bf2f(P[(size_t)row * PC + C_GD + h * 64 + v]);
                mix[(size_t)row * DM + 768 + h * 64 + v] = f2bf(acc[vt][r] * rs * p.gla_norm_g[l * 64 + v] * siluf(z));
            }
        }
    }
}

__device__ void pool_item(const Params& p, int l, int item, char* lds) {
    const int tile = item >> 2, g = item & 3, win = 2 << g;
    const int t = tid_opaque(), lane = t & 63, w = t >> 6, fr = lane & 15, fq = lane >> 4;
    float* Wl = (float*)lds;
    float* U = (float*)(lds + 16640);
    float* Pl = (float*)(lds + 28672);
    const bf16_t* P = (const bf16_t*)(p.ws + OFF_REG + R_P);
    bf16_t* mix = (bf16_t*)(p.ws + OFF_REG + R_MIX);
    int b, t0, row0; bool sample;
    if (tile < 512) { b = tile >> 6; t0 = (tile & 63) * 32; row0 = b * 2048 + t0; sample = false; }
    else { b = tile - 512; t0 = 0; row0 = NPROMPT + b * 32; sample = true; }
    __syncthreads();
    for (int e = t; e < 4096; e += 256) Wl[(e >> 6) * 65 + (e & 63)] = p.pool_w[((size_t)(l * 4 + g) * 64) * 64 + e];
    for (int e = t; e < 47 * 64; e += 256) {
        const int r = e >> 6, ch = e & 63, tt = r - 15;
        float v;
        if (t0 + tt >= 0) v = bf2f(P[(size_t)(row0 + tt) * PC + C_UA + g * 64 + ch]);
        else v = sample ? p.cache_pool[((size_t)(l * 32 + b) * 15 + (15 + tt)) * 256 + g * 64 + ch] : 0.f;
        U[e] = v;
    }
    __syncthreads();
    for (int e = t; e < 32 * 64; e += 256) {
        const int tt = e >> 6, ch = e & 63;
        float s = 0.f;
        for (int j = 0; j < win; ++j) s += U[(15 + tt - j) * 64 + ch];
        const int pos1 = t0 + tt + 1;
        const float cnt = (sample || pos1 > win) ? (float)win : (float)pos1;
        Pl[tt * 65 + ch] = s / cnt - U[(15 + tt) * 64 + ch];
    }
    __syncthreads();
#pragma unroll
    for (int mt = 0; mt < 2; ++mt) {
        f32x4 z = (f32x4){0.f, 0.f, 0.f, 0.f};
        f32x4 y = mm16(Pl + mt * 16 * 65, 65, 1, Wl + w * 16, 65, 1, 64, z, lane);
        const int d = g * 64 + w * 16 + fr;
        const float sc = p.pool_scale[l * 256 + d];
#pragma unroll
        for (int r = 0; r < 4; ++r) mix[(size_t)(row0 + mt * 16 + fq * 4 + r) * DM + d] = f2bf(y[r] * sc);
    }
}

__device__ void copy_outs(const Params& p, int l) {
    const bf16_t* P = (const bf16_t*)(p.ws + OFF_REG + R_P);
    const size_t gt = (size_t)blockIdx.x * 256 + tid_opaque(), gs = (size_t)gridDim.x * 256;
    for (size_t e = gt; e < 2 * 1048576; e += gs) {
        const int kv = (int)(e >> 20), r = (int)(e & 1048575), d = r & 63, j = (r >> 6) & 511, h = (r >> 15) & 3, b = r >> 17;
        p.out[(kv ? O_VP : O_KP) + (size_t)l * 1048576 + r] = bf2f(P[(size_t)(b * 2048 + 1536 + j) * PC + (kv ? C_VB : C_KB) + h * 64 + d]);
    }
    for (size_t e = gt; e < 2 * 262144; e += gs) {
        const int kv = (int)(e >> 18), r = (int)(e & 262143), d = r & 63, j = (r >> 6) & 31, h = (r >> 11) & 3, b = r >> 13;
        p.out[(kv ? O_VS : O_KS) + (size_t)l * 262144 + r] = bf2f(P[(size_t)(NPROMPT + b * 32 + j) * PC + (kv ? C_VB : C_KB) + h * 64 + d]);
    }
    for (size_t e = gt; e < 40 * 3840; e += gs) {
        const int bb = (int)(e / 3840), r = (int)(e % 3840), rr = r >> 8, ch = r & 255;
        if (bb < 8) p.out[O_POOLP + (size_t)l * 30720 + e] = bf2f(P[(size_t)(bb * 2048 + 2033 + rr) * PC + C_UA + ch]);
        else p.out[O_POOLS + (size_t)l * 122880 + (e - 30720)] = bf2f(P[(size_t)(NPROMPT + (bb - 8) * 32 + 17 + rr) * PC + C_UA + ch]);
    }
    for (size_t e = gt; e < 40 * 2304; e += gs) {
        const int bb = (int)(e / 2304), r = (int)(e % 2304), rr = r / 768, ch = r % 768;
        if (bb < 8) p.out[O_CONVP + (size_t)l * 18432 + e] = bf2f(P[(size_t)(bb * 2048 + 2045 + rr) * PC + C_QC + ch]);
        else p.out[O_CONVS + (size_t)l * 73728 + (e - 18432)] = bf2f(P[(size_t)(NPROMPT + (bb - 8) * 32 + 29 + rr) * PC + C_QC + ch]);
    }
}

__device__ void final_rows(const Params& p, int it) {
    const int w = tid_opaque() >> 6, lane = tid_opaque() & 63, row = it * 4 + w;
    const float* xres = (const float*)(p.ws + OFF_XRES) + (size_t)row * DM;
    const f32x4* pp = (const f32x4*)((const float*)(p.ws + OFF_SSQ) + (size_t)row * 16);
    const f32x4 pa = (pp[0] + pp[1]) + (pp[2] + pp[3]);
    const float rs = rsqrtf(((pa[0] + pa[1]) + (pa[2] + pa[3])) * (1.f / DM) + EPSV);
    float* y = p.out + (size_t)row * DM;
#pragma unroll
    for (int i = 0; i < 4; ++i) {
        const int c = lane * 4 + 256 * i;
        float4 v = *(const float4*)(xres + c); const float4 g = *(const float4*)(p.final_norm_g + c);
        v.x *= rs * g.x; v.y *= rs * g.y; v.z *= rs * g.z; v.w *= rs * g.w;
        *(float4*)(y + c) = v;
    }
}

__device__ void run_phase(const Params& p, int ph, char* lds) {
    const int G = gridDim.x, B = blockIdx.x;
    if (ph == 0) {
        for (int it = B; it < CV_TOTAL + NTOK / 4; it += G) {
            if (it < CV_TOTAL) convert_layer_item(p, 0, it, lds); else prologue_rows(p, it - CV_TOTAL);
        }
        return;
    }
    if (ph == 1 + 7 * DEPTH) { for (int it = B; it < NTOK / 4; it += G) final_rows(p, it); return; }
    const int l = (ph - 1) / 7, sp = (ph - 1) % 7;
    const bf16_t* wb = (const bf16_t*)(p.ws + ((l & 1) ? OFF_WB1 : OFF_WB0));
    float* ssq = (float*)(p.ws + OFF_SSQ);
    bf16_t* xb = (bf16_t*)(p.ws + OFF_XB);
    float* xres = (float*)(p.ws + OFF_XRES);
    EpiP e{};
    if (sp == 0) {
        e.obf = (bf16_t*)(p.ws + OFF_REG + R_P); e.ldo = PC; e.ssq_in = ssq;
        for (int it = B; it < 136 * 23; it += G) gemm_tile<0>(xb, DM, wb + WB_IN, DM, it / 23, it % 23, e, lds);
    } else if (sp == 1) {
        for (int it = B; it < 2 * NITEM; it += G) { if (it < NITEM) delta_prep(p, l, it, lds); else gla_prep(p, l, it - NITEM, lds); }
    } else if (sp == 2) {
        for (int it = B; it < 128 + 256 + NITEM + 512 + 1024; it += G) {
            int i = it;
            if (i < 128) delta_scan(p, l, i, lds);
            else if ((i -= 128) < 256) gla_scan(p, l, i);
            else if ((i -= 256) < NITEM) attn_item(p, l, i, lds);
            else if ((i -= NITEM) < 512) delta_scan(p, l, 128 + i, lds);
            else gla_scan(p, l, 256 + (i - 512));
        }
    } else if (sp == 3) {
        const int ncv = (l + 1 < DEPTH) ? CV_TOTAL : 0;
        for (int it = B; it < 2 * NITEM + 2176 + ncv; it += G) {
            int i = it;
            if (i < NITEM) delta_out(p, l, i, lds);
            else if ((i -= NITEM) < NITEM) gla_out(p, l, i, lds);
            else if ((i -= NITEM) < 2176) pool_item(p, l, i, lds);
            else convert_layer_item(p, l + 1, i - 2176, lds);
        }
        copy_outs(p, l);
    } else if (sp == 4) {
        e.xres = xres; e.xb = xb; e.ssq_out = ssq;
        for (int it = B; it < 136 * 8; it += G) gemm_tile<1>((const bf16_t*)(p.ws + OFF_REG + R_MIX), DM, wb + WB_OUT, DM, it / 8, it % 8, e, lds);
    } else if (sp == 5) {
        e.obf = (bf16_t*)(p.ws + OFF_REG); e.ldo = DFF; e.ssq_in = ssq;
        for (int it = B; it < 136 * 32; it += G) gemm_tile<2>(xb, DM, wb + WB_UP, DM, it / 32, it % 32, e, lds);
    } else {
        e.xres = xres; e.xb = xb; e.ssq_out = ssq;
        for (int it = B; it < 136 * 8; it += G) gemm_tile<1>((const bf16_t*)(p.ws + OFF_REG), DFF, wb + WB_DN, DFF, it / 8, it % 8, e, lds);
    }
}

#define XB_TMO      128
#define XB_XCNT(j)  (256  + 64 * (j))
#define XB_XSUB(j)  (1280 + 64 * (j))
#define XB_XGEN(j)  (2304 + 64 * (j))
#define XB_TOP      3328
#define XB_TOPGEN   3392
#define XCD_BAR_WORDS 3456
#define XB_SPIN_CAP (1u << 22)
#define LAS __attribute__((address_space(3)))
__device__ __forceinline__ unsigned xb_ld(unsigned* p)              { return __hip_atomic_load(p, __ATOMIC_RELAXED, __HIP_MEMORY_SCOPE_AGENT); }
__device__ __forceinline__ unsigned xb_add(unsigned* p, unsigned v) { return __hip_atomic_fetch_add(p, v, __ATOMIC_RELAXED, __HIP_MEMORY_SCOPE_AGENT); }
__device__ __forceinline__ unsigned xb_xcc_id() { return (unsigned)__builtin_amdgcn_s_getreg((3 << 11) | 20) & 0xFu; }
#define XB_SPIN(cond, bar) do { unsigned _sp = 0; while (cond) { __builtin_amdgcn_s_sleep(1); \
    if ((++_sp & 255u) == 0u) { if (xb_ld(&(bar)[XB_TMO])) break; if (_sp > XB_SPIN_CAP) { atomicAdd(&(bar)[XB_TMO], 1u); break; } } } } while (0)
struct XcdBarrier { unsigned* bar; unsigned x; volatile LAS unsigned* st; };
__device__ __forceinline__ XcdBarrier xcd_barrier_post(unsigned* bar, volatile LAS unsigned* st) {
    XcdBarrier b; b.bar = bar; b.x = xb_xcc_id(); b.st = st;
    if (threadIdx.x == 0) (void)xb_add(&bar[XB_XCNT(b.x)], 1u);
    return b;
}
__device__ __forceinline__ void xcd_barrier_complete(unsigned* bar, unsigned x, unsigned& nloc, unsigned& nx) {
    const unsigned G = gridDim.x * gridDim.y * gridDim.z;
    unsigned sum, cnt, mine, sp = 0u;
    for (;;) {
        sum = 0u; cnt = 0u; mine = 0u;
#pragma unroll
        for (unsigned j = 0; j < 16; ++j) { const unsigned c = xb_ld(&bar[XB_XCNT(j)]); sum += c; cnt += (c > 0u) ? 1u : 0u; mine = (j == x) ? c : mine; }
        if (sum == G) break;
        __builtin_amdgcn_s_sleep(1);
        if ((++sp & 255u) == 0u) { if (xb_ld(&bar[XB_TMO])) break; if (sp > XB_SPIN_CAP) { atomicAdd(&bar[XB_TMO], 1u); break; } }
    }
    nloc = mine > 0u ? mine : 1u; nx = cnt > 0u ? cnt : 1u;
}
__device__ __forceinline__ void xcd_barrier(const XcdBarrier& b) {
    asm volatile("s_waitcnt vmcnt(0)" ::: "memory");
    __syncthreads();
    if (threadIdx.x == 0) {
        unsigned* bar = b.bar;
        __builtin_amdgcn_s_waitcnt(0);
        unsigned nloc = b.st[0], nx = b.st[1];
        if (nloc == 0u) { xcd_barrier_complete(bar, b.x, nloc, nx); b.st[0] = nloc; b.st[1] = nx; }
        const unsigned old = xb_add(&bar[XB_XSUB(b.x)], 1u);
        const unsigned gen = old / nloc;
        if (old + 1u == (gen + 1u) * nloc) {
            __builtin_amdgcn_fence(__ATOMIC_RELEASE, "agent");
            asm volatile("s_waitcnt vmcnt(0)" ::: "memory");
            const unsigned og = xb_add(&bar[XB_TOP], 1u);
            const unsigned tg = og / nx;
            if (og + 1u == (tg + 1u) * nx) xb_add(&bar[XB_TOPGEN], 1u);
            else XB_SPIN(xb_ld(&bar[XB_TOPGEN]) == tg, bar);
            __builtin_amdgcn_fence(__ATOMIC_ACQUIRE, "agent");
            xb_add(&bar[XB_XGEN(b.x)], 1u);
            asm volatile("s_waitcnt vmcnt(0)" ::: "memory");
        } else {
            XB_SPIN(xb_ld(&bar[XB_XGEN(b.x)]) == gen, bar);
            __builtin_amdgcn_fence(__ATOMIC_ACQUIRE, "agent");
            asm volatile("s_waitcnt vmcnt(0)" ::: "memory");
        }
    }
    __syncthreads();
}

constexpr int NPHASE = 2 + 7 * DEPTH;

__global__ void __launch_bounds__(256, 2) mega(Params p) {
    extern __shared__ __attribute__((aligned(16))) char lds[];
    volatile LAS unsigned* st = (volatile LAS unsigned*)(lds + LDS_BYTES - 16);
    if (threadIdx.x == 0) { st[0] = 0u; st[1] = 0u; }
    __syncthreads();
    XcdBarrier xb = xcd_barrier_post(p.bar, st);
    for (int ph = p.ph_begin; ph < p.ph_end; ++ph) {
        run_phase(p, ph, lds);
        if (ph + 1 < p.ph_end) { if (p.use_cg) cg::this_grid().sync(); else xcd_barrier(xb); }
    }
}

extern "C" void kernel_launch(void* const* d_in, const int* in_sizes, int n_in, void* d_out, int out_size, void* d_ws, size_t ws_size, hipStream_t stream) {
    static int grid_blocks = 0;
    if (!grid_blocks) {
        int dev = 0, cus = 0, per_cu = 0;
        hipGetDevice(&dev);
        hipDeviceGetAttribute(&cus, hipDeviceAttributeMultiprocessorCount, dev);
        hipFuncSetAttribute((const void*)mega, hipFuncAttributeMaxDynamicSharedMemorySize, LDS_BYTES);
        hipOccupancyMaxActiveBlocksPerMultiprocessor(&per_cu, mega, 256, LDS_BYTES);
        if (per_cu < 1) per_cu = 1;
        grid_blocks = cus * per_cu;
    }
    if (ws_size < WS_NEED) { fprintf(stderr, "workspace too small: %zu < %zu\n", ws_size, (size_t)WS_NEED); return; }
    Params p{};
    const float** f = (const float**)&p;
    for (int i = 0; i < 25; ++i) f[i] = (const float*)d_in[i];
    p.out = (float*)d_out; p.ws = (char*)d_ws; p.bar = (unsigned*)((char*)d_ws + OFF_BAR); p.use_cg = 0; p.pad0 = 0;
    hipMemsetAsync(p.bar, 0, XCD_BAR_WORDS * 4, stream);
#if ONE_LAUNCH
    p.ph_begin = 0; p.ph_end = NPHASE;
    void* args[] = {&p};
    hipError_t e = hipLaunchCooperativeKernel((void*)mega, dim3(grid_blocks), dim3(256), args, LDS_BYTES, stream);
    if (e != hipSuccess) fprintf(stderr, "cooperative launch failed: %s (grid %d)\n", hipGetErrorString(e), grid_blocks);
#else
    for (int ph = 0; ph < NPHASE; ++ph) {
        p.ph_begin = ph; p.ph_end = ph + 1;
        hipLaunchKernelGGL(mega, dim3(grid_blocks), dim3(256), LDS_BYTES, stream, p);
    }
#endif
}
```

```cpp
#include <hip/hip_runtime.h>
#include <hip/hip_cooperative_groups.h>
#include <cstdio>
#include <cstdint>
namespace cg = cooperative_groups;

#ifndef ONE_LAUNCH
#define ONE_LAUNCH 1
#endif

typedef unsigned short bf16_t;
typedef short bf16x8 __attribute__((ext_vector_type(8)));
typedef float f32x4 __attribute__((ext_vector_type(4)));
typedef unsigned u32x4 __attribute__((ext_vector_type(4)));

constexpr int DM = 1024, NTOK = 17408, NPROMPT = 16384, PC = 2944, INC = 2840, DFF = 4096, DEPTH = 4;
constexpr int C_UA = 0, C_QB = 256, C_KB = 512, C_VB = 768, C_QC = 1024, C_ZC = 1792, C_AC = 2048, C_BC = 2052,
              C_QD = 2056, C_KD = 2184, C_VD = 2312, C_GD = 2568, C_GK = 2824;
constexpr int NITEM = 1152;
constexpr float EPSV = 1e-6f;
constexpr int LDS_BYTES = 77824;

constexpr size_t WB_IN = 0, WB_OUT = (size_t)PC * DM, WB_UP = WB_OUT + (size_t)DM * DM, WB_DN = WB_UP + (size_t)DFF * DM,
                 WB_ELEMS = WB_DN + (size_t)DM * DFF;
constexpr size_t OFF_WB0 = 0, OFF_WB1 = WB_ELEMS * 2, OFF_XRES = OFF_WB1 + WB_ELEMS * 2, OFF_XB = OFF_XRES + (size_t)NTOK * DM * 4,
                 OFF_SSQ = OFF_XB + (size_t)NTOK * DM * 2, OFF_REG = OFF_SSQ + (size_t)16 * NTOK * 4;
constexpr size_t R_P = 0, R_MIX = R_P + (size_t)NTOK * PC * 2, R_DM = R_MIX + (size_t)NTOK * DM * 2, R_DN = R_DM + (size_t)NITEM * 16384,
                 R_DR = R_DN + (size_t)NITEM * 16384, R_DO0 = R_DR + (size_t)NITEM * 8192, R_DS = R_DO0 + (size_t)NITEM * 8192,
                 R_GN = R_DS + (size_t)NITEM * 16384, R_GQ = R_GN + (size_t)NITEM * 8192, R_GO0 = R_GQ + (size_t)NITEM * 4096,
                 R_GD = R_GO0 + (size_t)NITEM * 8192, R_GS = R_GD + (size_t)NITEM * 128, R_END = R_GS + (size_t)NITEM * 8192;
constexpr size_t OFF_BAR = OFF_REG + R_END;
constexpr size_t WS_NEED = OFF_BAR + 16384;
static_assert((size_t)NTOK * DFF * 2 <= R_END, "up overlay");
constexpr size_t O_YP = 0, O_YS = 16777216, O_POOLP = O_YS + 1048576, O_KP = O_POOLP + 122880, O_VP = O_KP + 4194304, O_CONVP = O_VP + 4194304,
                 O_DELTAP = O_CONVP + 73728, O_GLAP = O_DELTAP + 524288, O_POOLS = O_GLAP + 262144, O_KS = O_POOLS + 491520, O_VS = O_KS + 1048576,
                 O_CONVS = O_VS + 1048576, O_DELTAS = O_CONVS + 294912, O_GLAS = O_DELTAS + 2097152;

struct Params {
    const float *x_prompt, *x_sample, *cache_pool, *cache_k, *cache_v, *state_conv, *state_delta, *state_gla;
    const float *attn_norm_g, *w_in, *pool_w, *pool_scale, *rel_bias, *conv_w, *a_log, *dt_bias, *delta_norm_g, *gla_w_gk, *gla_b_gk,
        *gla_norm_g, *w_out, *mlp_norm_g, *w_up, *w_down, *final_norm_g;
    float* out;
    char* ws;
    unsigned* bar;
    int ph_begin, ph_end, use_cg, pad0;
};

__device__ __forceinline__ float bf2f(bf16_t v) { return __uint_as_float(((unsigned)v) << 16); }
__device__ __forceinline__ bf16_t f2bf(float f) { unsigned u = __float_as_uint(f); u += 0x7fffu + ((u >> 16) & 1u); return (bf16_t)(u >> 16); }
__device__ __forceinline__ unsigned pack2(float lo, float hi) { return (unsigned)f2bf(lo) | ((unsigned)f2bf(hi) << 16); }
__device__ __forceinline__ float ldf(const float* p) { return *p; }
__device__ __forceinline__ float ldf(const bf16_t* p) { return bf2f(*p); }
__device__ __forceinline__ float wave_sum(float v) {
#pragma unroll
    for (int o = 32; o; o >>= 1) v += __shfl_xor(v, o);
    return v;
}
__device__ __forceinline__ float siluf(float x) { return x / (1.f + expf(-x)); }

template <typename TA, typename TB>
__device__ __forceinline__ f32x4 mm16(const TA* A, int a_rs, int a_cs, const TB* B, int b_rs, int b_cs, int K, f32x4 acc, int lane) {
    const int i = lane & 15, kq = lane >> 4;
    const TA* ap = A + i * a_rs + kq * a_cs;
    const TB* bp = B + kq * b_rs + i * b_cs;
    for (int k0 = 0; k0 < K; k0 += 32) {
        float a[8], b[8];
#pragma unroll
        for (int u = 0; u < 8; ++u) { a[u] = ldf(ap + (k0 + 4 * u) * a_cs); b[u] = ldf(bp + (k0 + 4 * u) * b_rs); }
#pragma unroll
        for (int u = 0; u < 8; ++u) acc = __builtin_amdgcn_mfma_f32_16x16x4f32(a[u], b[u], acc, 0, 0, 0);
    }
    return acc;
}
template <typename TA, typename TB>
__device__ __forceinline__ f32x4 mm16s(const TA* A, int a_rs, int a_cs, const TB* B, int b_rs, int b_cs, int K, f32x4 acc, int lane) {
    const int i = lane & 15, kq = lane >> 4;
    const TA* ap = A + i * a_rs + kq * a_cs;
    const TB* bp = B + kq * b_rs + i * b_cs;
    for (int k0 = 0; k0 < K; k0 += 16) {
        float a[4], b[4];
#pragma unroll
        for (int u = 0; u < 4; ++u) { a[u] = ldf(ap + (k0 + 4 * u) * a_cs); b[u] = ldf(bp + (k0 + 4 * u) * b_rs); }
#pragma unroll
        for (int u = 0; u < 4; ++u) acc = __builtin_amdgcn_mfma_f32_16x16x4f32(a[u], b[u], acc, 0, 0, 0);
    }
    return acc;
}

__device__ __forceinline__ int tid_opaque() { int t = threadIdx.x; asm volatile("" : "+v"(t)); return t; }
__device__ __forceinline__ const float* xin_row(const Params& p, int row) {
    return row < NPROMPT ? p.x_prompt + (size_t)row * DM : p.x_sample + (size_t)(row - NPROMPT) * DM;
}

__device__ void convert_tile(const float* __restrict__ src, bf16_t* __restrict__ dst, int K, int N, const float* __restrict__ g, int tile, char* lds) {
    float* T = (float*)lds;
    const int nkt = K >> 6, kt = tile % nkt, nt = tile / nkt, t = tid_opaque();
    __syncthreads();
#pragma unroll
    for (int i = 0; i < 4; ++i) {
        const int kl = (t >> 4) + 16 * i, k = kt * 64 + kl, nl = (t & 15) * 4, n0 = nt * 64 + nl;
        float4 v = make_float4(0.f, 0.f, 0.f, 0.f);
        if (n0 < N) v = *(const float4*)(src + (size_t)k * N + n0);
        if (g) { const float s = g[k]; v.x *= s; v.y *= s; v.z *= s; v.w *= s; }
        T[(nl + 0) * 65 + kl] = v.x; T[(nl + 1) * 65 + kl] = v.y; T[(nl + 2) * 65 + kl] = v.z; T[(nl + 3) * 65 + kl] = v.w;
    }
    __syncthreads();
    const int n = t >> 2, kc = (t & 3) * 16;
    const float* r = T + n * 65 + kc;
    uint4 a, b;
    a.x = pack2(r[0], r[1]); a.y = pack2(r[2], r[3]); a.z = pack2(r[4], r[5]); a.w = pack2(r[6], r[7]);
    b.x = pack2(r[8], r[9]); b.y = pack2(r[10], r[11]); b.z = pack2(r[12], r[13]); b.w = pack2(r[14], r[15]);
    bf16_t* d = dst + (size_t)(nt * 64 + n) * K + kt * 64 + kc;
    *(uint4*)d = a; *(uint4*)(d + 8) = b;
}
constexpr int CV_IN = 16 * 46, CV_OUT = 16 * 16, CV_UP = 16 * 64, CV_DN = 64 * 16, CV_TOTAL = CV_IN + CV_OUT + CV_UP + CV_DN;
__device__ void convert_layer_item(const Params& p, int l, int it, char* lds) {
    bf16_t* wb = (bf16_t*)(p.ws + ((l & 1) ? OFF_WB1 : OFF_WB0));
    if (it < CV_IN) convert_tile(p.w_in + (size_t)l * DM * INC, wb + WB_IN, DM, INC, p.attn_norm_g + l * DM, it, lds);
    else if ((it -= CV_IN) < CV_OUT) convert_tile(p.w_out + (size_t)l * DM * DM, wb + WB_OUT, DM, DM, nullptr, it, lds);
    else if ((it -= CV_OUT) < CV_UP) convert_tile(p.w_up + (size_t)l * DM * DFF, wb + WB_UP, DM, DFF, p.mlp_norm_g + l * DM, it, lds);
    else { it -= CV_UP; convert_tile(p.w_down + (size_t)l * DFF * DM, wb + WB_DN, DFF, DM, nullptr, it, lds); }
}

__device__ void prologue_rows(const Params& p, int it) {
    const int w = tid_opaque() >> 6, lane = tid_opaque() & 63, row = it * 4 + w;
    const float* x = xin_row(p, row);
    float* xres = (float*)(p.ws + OFF_XRES) + (size_t)row * DM;
    bf16_t* xb = (bf16_t*)(p.ws + OFF_XB) + (size_t)row * DM;
    float* ssq = (float*)(p.ws + OFF_SSQ);
    float s = 0.f;
#pragma unroll
    for (int i = 0; i < 4; ++i) {
        const int c = lane * 4 + 256 * i;
        float4 v = *(const float4*)(x + c);
        s += v.x * v.x + v.y * v.y + v.z * v.z + v.w * v.w;
        *(float4*)(xres + c) = v;
        uint2 o; o.x = pack2(v.x, v.y); o.y = pack2(v.z, v.w);
        *(uint2*)(xb + c) = o;
    }
    s = wave_sum(s);
    if (lane < 16) ssq[(size_t)row * 16 + lane] = lane == 0 ? s : 0.f;
}

struct EpiP { bf16_t* obf; int ldo; float* xres; bf16_t* xb; const float* ssq_in; float* ssq_out; };
constexpr int GLD = 64;
template <int EPI>
__device__ void gemm_tile(const bf16_t* __restrict__ A, int lda, const bf16_t* __restrict__ Bt, int K, int tm, int tn, const EpiP& e, char* lds) {
    const int t = tid_opaque(), lane = t & 63, w = t >> 6, wm = w >> 1, wn = w & 1, fr = lane & 15, fq = lane >> 4;
    const int lr = t >> 3, lc = (t & 7) * 8, lcs = ((t & 7) ^ ((lr >> 1) & 7)) * 8, rsw = fr >> 1;
    const bf16_t* ag = A + (size_t)(tm * 128 + lr) * lda + lc;
    const bf16_t* bg = Bt + (size_t)(tn * 128 + lr) * K + lc;
    f32x4 acc[4][4];
#pragma unroll
    for (int i = 0; i < 4; ++i)
#pragma unroll
        for (int j = 0; j < 4; ++j) acc[i][j] = (f32x4){0.f, 0.f, 0.f, 0.f};
    u32x4 ra[4], rb[4];
#pragma unroll
    for (int i = 0; i < 4; ++i) { ra[i] = *(const u32x4*)(ag + (size_t)(32 * i) * lda); rb[i] = *(const u32x4*)(bg + (size_t)(32 * i) * K); }
    __syncthreads();
    {
        bf16_t* As = (bf16_t*)lds; bf16_t* Bs = As + 128 * GLD;
#pragma unroll
        for (int i = 0; i < 4; ++i) { *(u32x4*)(As + (lr + 32 * i) * GLD + lcs) = ra[i]; *(u32x4*)(Bs + (lr + 32 * i) * GLD + lcs) = rb[i]; }
    }
    __syncthreads();
    const int nk = K >> 6;
    for (int kt = 0; kt < nk; ++kt) {
        const bf16_t* As = (const bf16_t*)(lds + (kt & 1) * (256 * GLD * 2)); const bf16_t* Bs = As + 128 * GLD;
        if (kt + 1 < nk) {
#pragma unroll
            for (int i = 0; i < 4; ++i) { ra[i] = *(const u32x4*)(ag + (size_t)(32 * i) * lda + (kt + 1) * 64); rb[i] = *(const u32x4*)(bg + (size_t)(32 * i) * K + (kt + 1) * 64); }
        }
#pragma unroll
        for (int kh = 0; kh < 2; ++kh) {
            bf16x8 af[4], bfr[4];
#pragma unroll
            for (int i = 0; i < 4; ++i) {
                af[i] = *(const bf16x8*)(As + (wm * 64 + i * 16 + fr) * GLD + (((kh * 4 + fq) ^ rsw) * 8));
                bfr[i] = *(const bf16x8*)(Bs + (wn * 64 + i * 16 + fr) * GLD + (((kh * 4 + fq) ^ rsw) * 8));
            }
#pragma unroll
            for (int i = 0; i < 4; ++i)
#pragma unroll
                for (int j = 0; j < 4; ++j) acc[i][j] = __builtin_amdgcn_mfma_f32_16x16x32_bf16(bfr[j], af[i], acc[i][j], 0, 0, 0);
        }
        if (kt + 1 < nk) {
            bf16_t* An = (bf16_t*)(lds + ((kt + 1) & 1) * (256 * GLD * 2)); bf16_t* Bn = An + 128 * GLD;
#pragma unroll
            for (int i = 0; i < 4; ++i) { *(u32x4*)(An + (lr + 32 * i) * GLD + lcs) = ra[i]; *(u32x4*)(Bn + (lr + 32 * i) * GLD + lcs) = rb[i]; }
        }
        __syncthreads();
    }
#pragma unroll
    for (int i = 0; i < 4; ++i) {
        const int row = tm * 128 + wm * 64 + i * 16 + fr;
        float rs = 1.f;
        if (EPI == 0 || EPI == 2) {
            const f32x4* pp = (const f32x4*)(e.ssq_in + (size_t)row * 16);
            const f32x4 a = (pp[0] + pp[1]) + (pp[2] + pp[3]);
            rs = rsqrtf(((a[0] + a[1]) + (a[2] + a[3])) * (1.f / DM) + EPSV);
        }
        float sq = 0.f;
#pragma unroll
        for (int j = 0; j < 4; ++j) {
            const int col = tn * 128 + wn * 64 + j * 16 + fq * 4;
            f32x4 v = acc[i][j];
            if (EPI == 0) {
                uint2 o; o.x = pack2(v[0] * rs, v[1] * rs); o.y = pack2(v[2] * rs, v[3] * rs);
                *(uint2*)(e.obf + (size_t)row * e.ldo + col) = o;
            } else if (EPI == 2) {
                float a0 = fmaxf(v[0] * rs, 0.f), a1 = fmaxf(v[1] * rs, 0.f), a2 = fmaxf(v[2] * rs, 0.f), a3 = fmaxf(v[3] * rs, 0.f);
                uint2 o; o.x = pack2(a0 * a0, a1 * a1); o.y = pack2(a2 * a2, a3 * a3);
                *(uint2*)(e.obf + (size_t)row * e.ldo + col) = o;
            } else {
                float4 x = *(const float4*)(e.xres + (size_t)row * DM + col);
                x.x += v[0]; x.y += v[1]; x.z += v[2]; x.w += v[3];
                *(float4*)(e.xres + (size_t)row * DM + col) = x;
                uint2 o; o.x = pack2(x.x, x.y); o.y = pack2(x.z, x.w);
                *(uint2*)(e.xb + (size_t)row * DM + col) = o;
                sq += x.x * x.x + x.y * x.y + x.z * x.z + x.w * x.w;
            }
        }
        if (EPI == 1) {
            sq += __shfl_xor(sq, 16); sq += __shfl_xor(sq, 32);
            if (fq == 0) e.ssq_out[(size_t)row * 16 + tn * 2 + wn] = sq;
        }
    }
}

struct Item { int b, h, c, cs, row0; bool sample; };
__device__ __forceinline__ Item decode_item(int item) {
    Item r;
    if (item < 1024) { r.b = item >> 7; r.h = (item >> 5) & 3; r.c = item & 31; r.cs = 64; r.row0 = r.b * 2048 + r.c * 64; r.sample = false; }
    else { const int s = item - 1024; r.b = s >> 2; r.h = s & 3; r.c = 0; r.cs = 32; r.row0 = NPROMPT + r.b * 32; r.sample = true; }
    return r;
}

__device__ void delta_prep(const Params& p, int l, int item, char* lds) {
    const Item it = decode_item(item);
    const int cs = it.cs, h = it.h, t = tid_opaque(), lane = t & 63, w = t >> 6, fr = lane & 15, fq = lane >> 4;
    float* Ks = (float*)lds;
    float* X = (float*)(lds + 16640);
    float* Am = (float*)(lds + 49664);
    bf16_t* QKm = (bf16_t*)(lds + 66304);
    float* Gs = (float*)(lds + 74752);
    float* Bs = (float*)(lds + 75008);
    const bf16_t* P = (const bf16_t*)(p.ws + OFF_REG + R_P);
    const float* cw = p.conv_w + (size_t)l * 4 * 768;
    const float* hist = p.state_conv + (size_t)(l * 32 + it.b) * 3 * 768;
    bf16_t* Raw = (bf16_t*)(lds + 49664);
    __syncthreads();
    for (int e = t; e < (cs + 3) * 24; e += 256) {
        const int r = e / 24, ci = e - r * 24, which = ci >> 3, d0 = (ci & 7) * 8, tt = r - 3, cwi = which * 256 + h * 64 + d0;
        u32x4 v = (u32x4){0u, 0u, 0u, 0u};
        if (tt >= 0 || (!it.sample && it.c > 0)) v = *(const u32x4*)(P + (size_t)(it.row0 + tt) * PC + C_QC + cwi);
        else if (it.sample) {
            const float4 a = *(const float4*)(hist + (3 + tt) * 768 + cwi), b = *(const float4*)(hist + (3 + tt) * 768 + cwi + 4);
            v[0] = pack2(a.x, a.y); v[1] = pack2(a.z, a.w); v[2] = pack2(b.x, b.y); v[3] = pack2(b.z, b.w);
        }
        *(u32x4*)(Raw + r * 192 + ci * 8) = v;
    }
    __syncthreads();
    for (int e = t; e < cs * 192; e += 256) {
        const int tok = e / 192, ch = e - tok * 192, which = ch >> 6, d = ch & 63, cwi = which * 256 + h * 64 + d;
        float acc = 0.f;
#pragma unroll
        for (int j = 0; j < 4; ++j) acc += bf2f(Raw[(tok + j) * 192 + ch]) * cw[j * 768 + cwi];
        const float cv = siluf(acc);
        if (which == 0) X[tok * 129 + 64 + d] = cv; else if (which == 1) Ks[tok * 65 + d] = cv; else X[tok * 129 + d] = cv;
    }
    __syncthreads();
    for (int tok = w; tok < cs; tok += 4) {
        const float kv = Ks[tok * 65 + lane], qv = X[tok * 129 + 64 + lane];
        const float sk = wave_sum(kv * kv), sq = wave_sum(qv * qv);
        Ks[tok * 65 + lane] = kv * rsqrtf(sk + EPSV);
        X[tok * 129 + 64 + lane] = qv * rsqrtf(sq + EPSV) * 0.125f;
    }
    if (t < cs) {
        const float a = bf2f(P[(size_t)(it.row0 + t) * PC + C_AC + h]), bb = bf2f(P[(size_t)(it.row0 + t) * PC + C_BC + h]);
        const float xs = a + p.dt_bias[l * 4 + h];
        const float sp = xs > 20.f ? xs : log1pf(expf(xs));
        Gs[t] = -expf(p.a_log[l * 4 + h]) * sp;
        Bs[t] = 1.f / (1.f + expf(-bb));
    }
    __syncthreads();
    if (w == 0) {
        float v = lane < cs ? Gs[lane] : 0.f;
#pragma unroll
        for (int o = 1; o < 64; o <<= 1) { const float n = __shfl_up(v, o); if (lane >= o) v += n; }
        if (lane < cs) Gs[lane] = v;
    }
    __syncthreads();
    const bool act = (w * 16 < cs);
    f32x4 qreg[4];
    if (act) {
        f32x4 aK[4], aQ[4];
#pragma unroll
        for (int jt = 0; jt < 4; ++jt) {
            aK[jt] = (f32x4){0.f, 0.f, 0.f, 0.f}; aQ[jt] = aK[jt];
            if (jt * 16 < cs) {
                aK[jt] = mm16(Ks + w * 16 * 65, 65, 1, Ks + jt * 16 * 65, 1, 65, 64, aK[jt], lane);
                aQ[jt] = mm16(X + w * 16 * 129 + 64, 129, 1, Ks + jt * 16 * 65, 1, 65, 64, aQ[jt], lane);
            }
        }
#pragma unroll
        for (int nt = 0; nt < 4; ++nt)
#pragma unroll
            for (int r = 0; r < 4; ++r) { const int i = w * 16 + fq * 4 + r; qreg[nt][r] = X[i * 129 + 64 + nt * 16 + fr] * expf(Gs[i]); }
#pragma unroll
        for (int jt = 0; jt < 4; ++jt)
            if (jt * 16 < cs) {
#pragma unroll
                for (int r = 0; r < 4; ++r) {
                    const int i = w * 16 + fq * 4 + r, j = jt * 16 + fr;
                    const float dec = (j <= i) ? expf(Gs[i] - Gs[j]) : 0.f;
                    Am[i * 65 + j] = (j < i) ? Bs[i] * aK[jt][r] * dec : 0.f;
                    QKm[i * 66 + j] = f2bf(aQ[jt][r] * dec);
                }
            }
    }
    __syncthreads();
    for (int e = t; e < cs * 64; e += 256) {
        const int i = e >> 6, d = e & 63;
        const float b = Bs[i];
        X[i * 129 + 64 + d] = b * expf(Gs[i]) * Ks[i * 65 + d];
        X[i * 129 + d] *= b;
    }
    __syncthreads();
    for (int r0 = 0; r0 < cs; r0 += 16) {
        if (r0 > 0) {
#pragma unroll
            for (int q2 = 0; q2 < 2; ++q2) {
                const int ct = w * 2 + q2;
                f32x4 z = (f32x4){0.f, 0.f, 0.f, 0.f};
                const f32x4 c = mm16s(Am + r0 * 65, 65, 1, X + ct * 16, 129, 1, r0, z, lane);
#pragma unroll
                for (int r = 0; r < 4; ++r) X[(r0 + fq * 4 + r) * 129 + ct * 16 + fr] -= c[r];
            }
            __syncthreads();
        }
        if (t < 128) {
            float x[16];
#pragma unroll
            for (int i = 0; i < 16; ++i) x[i] = X[(r0 + i) * 129 + t];
#pragma unroll
            for (int i = 1; i < 16; ++i) {
                const float* ar = Am + (r0 + i) * 65 + r0;
#pragma unroll
                for (int j = 0; j < i; ++j) x[i] -= ar[j] * x[j];
            }
#pragma unroll
            for (int i = 1; i < 16; ++i) X[(r0 + i) * 129 + t] = x[i];
        }
        __syncthreads();
    }
    const float gl = Gs[cs - 1];
    for (int e = t; e < cs * 64; e += 256) { const int i = e >> 6, d = e & 63; Ks[i * 65 + d] *= expf(gl - Gs[i]); }
    __syncthreads();
    float* oM = (float*)(p.ws + OFF_REG + R_DM) + (size_t)item * 4096;
    float* oN = (float*)(p.ws + OFF_REG + R_DN) + (size_t)item * 4096;
    bf16_t* oR = (bf16_t*)(p.ws + OFF_REG + R_DR) + (size_t)item * 4096;
    bf16_t* oO = (bf16_t*)(p.ws + OFF_REG + R_DO0) + (size_t)item * 4096;
    const float egl = expf(gl);
#pragma unroll
    for (int bt = 0; bt < 4; ++bt) {
        f32x4 z = (f32x4){0.f, 0.f, 0.f, 0.f};
        f32x4 cm = mm16(Ks + w * 16, 1, 65, X + 64 + bt * 16, 129, 1, cs, z, lane);
        f32x4 cn = mm16(Ks + w * 16, 1, 65, X + bt * 16, 129, 1, cs, z, lane);
#pragma unroll
        for (int r = 0; r < 4; ++r) {
            const int a = w * 16 + fq * 4 + r, b = bt * 16 + fr;
            oM[a * 64 + b] = ((a == b) ? egl : 0.f) - cm[r];
            oN[a * 64 + b] = cn[r];
        }
    }
    if (act) {
#pragma unroll
        for (int bt = 0; bt < 4; ++bt) {
            f32x4 z = (f32x4){0.f, 0.f, 0.f, 0.f};
            f32x4 cr = mm16(QKm + w * 16 * 66, 66, 1, X + 64 + bt * 16, 129, 1, cs, z, lane);
            f32x4 co = mm16(QKm + w * 16 * 66, 66, 1, X + bt * 16, 129, 1, cs, z, lane);
#pragma unroll
            for (int r = 0; r < 4; ++r) {
                const int i = w * 16 + fq * 4 + r, b = bt * 16 + fr;
                oR[i * 64 + b] = f2bf(qreg[bt][r] - cr[r]);
                oO[i * 64 + b] = f2bf(co[r]);
            }
        }
    }
}

__device__ void gla_prep(const Params& p, int l, int item, char* lds) {
    const Item it = decode_item(item);
    const int cs = it.cs, h = it.h, t = tid_opaque(), lane = t & 63, w = t >> 6, fr = lane & 15, fq = lane >> 4;
    float* Qg = (float*)lds;
    float* Kn = (float*)(lds + 8448);
    float* Kd = (float*)(lds + 16896);
    float* Gs = (float*)(lds + 25344);
    float* Vs = (float*)(lds + 33792);
    float* Att = (float*)(lds + 50432);
    const bf16_t* P = (const bf16_t*)(p.ws + OFF_REG + R_P);
    float* GL = (float*)(lds + 67072);
    float* WG = (float*)(lds + 71424);
    float* Tot = (float*)(lds + 73472);
    __syncthreads();
    for (int e = t; e < cs * 16; e += 256) GL[(e >> 4) * 17 + (e & 15)] = bf2f(P[(size_t)(it.row0 + (e >> 4)) * PC + C_GK + (e & 15)]);
    for (int e = t; e < 512; e += 256) WG[e] = p.gla_w_gk[(size_t)(l * 16 + (e >> 5)) * 128 + h * 32 + (e & 31)];
    __syncthreads();
    for (int e = t; e < cs * 32; e += 256) {
        const int tok = e >> 5, kk = e & 31;
        const bf16_t* pr = P + (size_t)(it.row0 + tok) * PC;
        Qg[tok * 33 + kk] = bf2f(pr[C_QD + h * 32 + kk]);
        Kn[tok * 33 + kk] = bf2f(pr[C_KD + h * 32 + kk]);
        float x = p.gla_b_gk[l * 128 + h * 32 + kk];
#pragma unroll
        for (int r = 0; r < 16; ++r) x += GL[tok * 17 + r] * WG[r * 32 + kk];
        const float ls = fminf(x, 0.f) - log1pf(expf(-fabsf(x)));
        Gs[tok * 33 + kk] = ls * (1.f / 16.f);
    }
    for (int e = t; e < cs * 64; e += 256) {
        const int tok = e >> 6, d = e & 63;
        Vs[tok * 65 + d] = bf2f(P[(size_t)(it.row0 + tok) * PC + C_VD + h * 64 + d]);
    }
    __syncthreads();
    {
        const int kk = t & 31, part = t >> 5, n = cs >> 3;
        float loc = 0.f;
        for (int i = 0; i < n; ++i) loc += Gs[(part * n + i) * 33 + kk];
        Tot[part * 32 + kk] = loc;
        __syncthreads();
        float base = 0.f;
        for (int pp = 0; pp < part; ++pp) base += Tot[pp * 32 + kk];
        for (int i = 0; i < n; ++i) { base += Gs[(part * n + i) * 33 + kk]; Gs[(part * n + i) * 33 + kk] = base; }
    }
    __syncthreads();
    bf16_t* oQ = (bf16_t*)(p.ws + OFF_REG + R_GQ) + (size_t)item * 2048;
    for (int e = t; e < cs * 32; e += 256) {
        const int tok = e >> 5, kk = e & 31;
        const float G = Gs[tok * 33 + kk], gl = Gs[(cs - 1) * 33 + kk], q = Qg[tok * 33 + kk], k = Kn[tok * 33 + kk];
        const float qg = q * 0.17677669529663687f * expf(G);
        Qg[tok * 33 + kk] = qg; Kn[tok * 33 + kk] = k * expf(-G); Kd[tok * 33 + kk] = k * expf(gl - G);
        oQ[tok * 32 + kk] = f2bf(qg);
    }
    if (t < 32) ((float*)(p.ws + OFF_REG + R_GD))[(size_t)item * 32 + t] = expf(Gs[(cs - 1) * 33 + t]);
    __syncthreads();
    const bool act = (w * 16 < cs);
    if (act) {
#pragma unroll
        for (int jt = 0; jt < 4; ++jt)
            if (jt * 16 < cs) {
                f32x4 z = (f32x4){0.f, 0.f, 0.f, 0.f};
                f32x4 a = mm16(Qg + w * 16 * 33, 33, 1, Kn + jt * 16 * 33, 1, 33, 32, z, lane);
#pragma unroll
                for (int r = 0; r < 4; ++r) { const int i = w * 16 + fq * 4 + r, j = jt * 16 + fr; Att[i * 65 + j] = (j <= i) ? a[r] : 0.f; }
            }
    }
    float* oN = (float*)(p.ws + OFF_REG + R_GN) + (size_t)item * 2048;
#pragma unroll
    for (int q2 = 0; q2 < 2; ++q2) {
        const int tile = w + 4 * q2, at = tile >> 2, vt = tile & 3;
        f32x4 z = (f32x4){0.f, 0.f, 0.f, 0.f};
        f32x4 cn = mm16(Kd + at * 16, 1, 33, Vs + vt * 16, 65, 1, cs, z, lane);
#pragma unroll
        for (int r = 0; r < 4; ++r) oN[(at * 16 + fq * 4 + r) * 64 + vt * 16 + fr] = cn[r];
    }
    __syncthreads();
    if (act) {
        bf16_t* oO = (bf16_t*)(p.ws + OFF_REG + R_GO0) + (size_t)item * 4096;
#pragma unroll
        for (int vt = 0; vt < 4; ++vt) {
            f32x4 z = (f32x4){0.f, 0.f, 0.f, 0.f};
            f32x4 co = mm16(Att + w * 16 * 65, 65, 1, Vs + vt * 16, 65, 1, cs, z, lane);
#pragma unroll
            for (int r = 0; r < 4; ++r) oO[(w * 16 + fq * 4 + r) * 64 + vt * 16 + fr] = f2bf(co[r]);
        }
    }
}

__device__ void delta_scan(const Params& p, int l, int idx, char* lds) {
    const int t = tid_opaque(), lane = t & 63, w = t >> 6, fr = lane & 15, fq = lane >> 4;
    float* Sl = (float*)lds;
    int item0, nsteps, v0; float* outp; const float* s0 = nullptr;
    if (idx < 128) { const int bh = idx >> 2; v0 = (idx & 3) * 16; item0 = bh * 32; nsteps = 32; outp = p.out + O_DELTAP + ((size_t)l * 32 + bh) * 4096; }
    else { const int s = idx - 128, bh = s >> 2; v0 = (s & 3) * 16; item0 = 1024 + bh; nsteps = 1; outp = p.out + O_DELTAS + ((size_t)l * 128 + bh) * 4096;
           s0 = p.state_delta + ((size_t)l * 128 + bh) * 4096; }
    const float* gM = (const float*)(p.ws + OFF_REG + R_DM);
    const float* gN = (const float*)(p.ws + OFF_REG + R_DN);
    float* gS = (float*)(p.ws + OFF_REG + R_DS);
    f32x4 sreg;
#pragma unroll
    for (int r = 0; r < 4; ++r) sreg[r] = s0 ? s0[(w * 16 + fq * 4 + r) * 64 + v0 + fr] : 0.f;
    __syncthreads();
#pragma unroll
    for (int r = 0; r < 4; ++r) Sl[(w * 16 + fq * 4 + r) * 17 + fr] = sreg[r];
    __syncthreads();
    for (int c = 0; c < nsteps; ++c) {
        const size_t ib = (size_t)(item0 + c) * 4096;
        float aM[16];
#pragma unroll
        for (int kk = 0; kk < 16; ++kk) aM[kk] = gM[ib + (w * 16 + fr) * 64 + kk * 4 + fq];
        f32x4 acc;
#pragma unroll
        for (int r = 0; r < 4; ++r) { const int a = w * 16 + fq * 4 + r; acc[r] = gN[ib + a * 64 + v0 + fr]; gS[ib + a * 64 + v0 + fr] = sreg[r]; }
#pragma unroll
        for (int kk = 0; kk < 16; ++kk) acc = __builtin_amdgcn_mfma_f32_16x16x4f32(aM[kk], Sl[(kk * 4 + fq) * 17 + fr], acc, 0, 0, 0);
        __syncthreads();
        sreg = acc;
#pragma unroll
        for (int r = 0; r < 4; ++r) Sl[(w * 16 + fq * 4 + r) * 17 + fr] = sreg[r];
        __syncthreads();
    }
#pragma unroll
    for (int r = 0; r < 4; ++r) outp[(w * 16 + fq * 4 + r) * 64 + v0 + fr] = sreg[r];
}

__device__ void gla_scan(const Params& p, int l, int idx) {
    const int t = tid_opaque();
    int item0, nsteps, e; float* outp; float S = 0.f;
    if (idx < 256) { const int bh = idx >> 3; e = (idx & 7) * 256 + t; item0 = bh * 32; nsteps = 32; outp = p.out + O_GLAP + ((size_t)l * 32 + bh) * 2048; }
    else { const int s = idx - 256, bh = s >> 3; e = (s & 7) * 256 + t; item0 = 1024 + bh; nsteps = 1; outp = p.out + O_GLAS + ((size_t)l * 128 + bh) * 2048;
           S = p.state_gla[((size_t)l * 128 + bh) * 2048 + e]; }
    const float* gN = (const float*)(p.ws + OFF_REG + R_GN);
    const float* gD = (const float*)(p.ws + OFF_REG + R_GD);
    float* gS = (float*)(p.ws + OFF_REG + R_GS);
    const int a = e >> 6;
    for (int c = 0; c < nsteps; ++c) {
        const size_t ib = (size_t)(item0 + c);
        gS[ib * 2048 + e] = S;
        S = gD[ib * 32 + a] * S + gN[ib * 2048 + e];
    }
    outp[e] = S;
}

__device__ void attn_item(const Params& p, int l, int item, char* lds) {
    bf16_t* Ks = (bf16_t*)lds;
    bf16_t* Vt = (bf16_t*)(lds + 9216);
    float* bias = (float*)(lds + 18432);
    const bf16_t* P = (const bf16_t*)(p.ws + OFF_REG + R_P);
    bf16_t* mix = (bf16_t*)(p.ws + OFF_REG + R_MIX);
    const int t = tid_opaque(), lane = t & 63, w = t >> 6, fr = lane & 15, fq = lane >> 4;
    int b, h, c = 0, nq, qrow0, nkb, kb0 = 0; bool sample;
    if (item < 1024) { b = item >> 7; c = (item >> 2) & 31; h = item & 3; nq = 64; qrow0 = b * 2048 + c * 64; kb0 = c > 8 ? c - 8 : 0; nkb = c - kb0 + 1; sample = false; }
    else { const int s = item - 1024; b = s >> 2; h = s & 3; nq = 32; qrow0 = NPROMPT + b * 32; nkb = 9; sample = true; }
    __syncthreads();
    for (int i = t; i < 513; i += 256) bias[i] = p.rel_bias[(size_t)(l * 4 + h) * 513 + i];
    const bool act = (w * 16 < nq);
    bf16x8 qf0 = {0, 0, 0, 0, 0, 0, 0, 0}, qf1 = qf0;
    if (act) { const bf16_t* qp = P + (size_t)(qrow0 + w * 16 + fr) * PC + C_QB + h * 64 + fq * 8; qf0 = *(const bf16x8*)qp; qf1 = *(const bf16x8*)(qp + 32); }
    float m = -1e30f, lsum = 0.f;
    f32x4 o[4];
#pragma unroll
    for (int i = 0; i < 4; ++i) o[i] = (f32x4){0.f, 0.f, 0.f, 0.f};
    const int qi = w * 16 + fr;
    const int key = t >> 2, dc = (t & 3) * 16;
    for (int kb = 0; kb < nkb; ++kb) {
        int nvalid = 64, relbase;
        uint4 k0, k1, v0, v1;
        if (!sample) {
            relbase = (kb0 + kb - c) * 64;
            const bf16_t* kp = P + (size_t)(b * 2048 + (kb0 + kb) * 64 + key) * PC + C_KB + h * 64 + dc;
            k0 = *(const uint4*)kp; k1 = *(const uint4*)(kp + 8); v0 = *(const uint4*)(kp + 256); v1 = *(const uint4*)(kp + 264);
        } else if (kb < 8) {
            relbase = kb * 64 - 512;
            const size_t off = ((((size_t)l * 32 + b) * 4 + h) * 512 + kb * 64 + key) * 64 + dc;
            const float4* kp = (const float4*)(p.cache_k + off); const float4* vp = (const float4*)(p.cache_v + off);
            float4 a = kp[0], bb = kp[1], cc = kp[2], dd = kp[3];
            k0.x = pack2(a.x, a.y); k0.y = pack2(a.z, a.w); k0.z = pack2(bb.x, bb.y); k0.w = pack2(bb.z, bb.w);
            k1.x = pack2(cc.x, cc.y); k1.y = pack2(cc.z, cc.w); k1.z = pack2(dd.x, dd.y); k1.w = pack2(dd.z, dd.w);
            a = vp[0]; bb = vp[1]; cc = vp[2]; dd = vp[3];
            v0.x = pack2(a.x, a.y); v0.y = pack2(a.z, a.w); v0.z = pack2(bb.x, bb.y); v0.w = pack2(bb.z, bb.w);
            v1.x = pack2(cc.x, cc.y); v1.y = pack2(cc.z, cc.w); v1.z = pack2(dd.x, dd.y); v1.w = pack2(dd.z, dd.w);
        } else {
            relbase = 0; nvalid = 32;
            k0 = make_uint4(0, 0, 0, 0); k1 = k0; v0 = k0; v1 = k0;
            if (key < 32) {
                const bf16_t* kp = P + (size_t)(NPROMPT + b * 32 + key) * PC + C_KB + h * 64 + dc;
                k0 = *(const uint4*)kp; k1 = *(const uint4*)(kp + 8); v0 = *(const uint4*)(kp + 256); v1 = *(const uint4*)(kp + 264);
            }
        }
        __syncthreads();
        *(uint4*)(Ks + key * 72 + dc) = k0; *(uint4*)(Ks + key * 72 + dc + 8) = k1;
        {
            const unsigned vv[8] = {v0.x, v0.y, v0.z, v0.w, v1.x, v1.y, v1.z, v1.w};
#pragma unroll
            for (int j = 0; j < 8; ++j) { Vt[(dc + 2 * j) * 72 + key] = (bf16_t)(vv[j] & 0xffffu); Vt[(dc + 2 * j + 1) * 72 + key] = (bf16_t)(vv[j] >> 16); }
        }
        __syncthreads();
        if (act) {
            f32x4 s[4];
#pragma unroll
            for (int tt = 0; tt < 4; ++tt) {
                const bf16_t* kr = Ks + (tt * 16 + fr) * 72 + fq * 8;
                f32x4 z = (f32x4){0.f, 0.f, 0.f, 0.f};
                z = __builtin_amdgcn_mfma_f32_16x16x32_bf16(*(const bf16x8*)kr, qf0, z, 0, 0, 0);
                z = __builtin_amdgcn_mfma_f32_16x16x32_bf16(*(const bf16x8*)(kr + 32), qf1, z, 0, 0, 0);
                s[tt] = z;
            }
            float mb = -1e30f;
#pragma unroll
            for (int tt = 0; tt < 4; ++tt)
#pragma unroll
                for (int r = 0; r < 4; ++r) {
                    const int kj = tt * 16 + fq * 4 + r;
                    int rel = relbase + kj - qi; rel = rel < -256 ? -256 : (rel > 256 ? 256 : rel);
                    float sc = s[tt][r] * 0.125f + bias[rel + 256];
                    sc = (kj < nvalid) ? sc : -1e30f;
                    s[tt][r] = sc; mb = fmaxf(mb, sc);
                }
            mb = fmaxf(mb, __shfl_xor(mb, 16)); mb = fmaxf(mb, __shfl_xor(mb, 32));
            const float mn = fmaxf(m, mb), alpha = __expf(m - mn);
            m = mn;
            float ps = 0.f;
#pragma unroll
            for (int tt = 0; tt < 4; ++tt)
#pragma unroll
                for (int r = 0; r < 4; ++r) { const float pv = __expf(s[tt][r] - mn); s[tt][r] = pv; ps += pv; }
            lsum = lsum * alpha + ps;
#pragma unroll
            for (int dt = 0; dt < 4; ++dt) o[dt] *= alpha;
#pragma unroll
            for (int u = 0; u < 2; ++u) {
                union { bf16x8 v; unsigned q[4]; } pf;
                pf.q[0] = pack2(s[2 * u][0], s[2 * u][1]); pf.q[1] = pack2(s[2 * u][2], s[2 * u][3]);
                pf.q[2] = pack2(s[2 * u + 1][0], s[2 * u + 1][1]); pf.q[3] = pack2(s[2 * u + 1][2], s[2 * u + 1][3]);
#pragma unroll
                for (int dt = 0; dt < 4; ++dt) {
                    const bf16_t* vr = Vt + (dt * 16 + fr) * 72 + u * 32 + fq * 4;
                    union { bf16x8 v; uint2 q[2]; } vf;
                    vf.q[0] = *(const uint2*)vr; vf.q[1] = *(const uint2*)(vr + 16);
                    o[dt] = __builtin_amdgcn_mfma_f32_16x16x32_bf16(vf.v, pf.v, o[dt], 0, 0, 0);
                }
            }
        }
    }
    if (act) {
        lsum += __shfl_xor(lsum, 16); lsum += __shfl_xor(lsum, 32);
        const float inv = 1.f / lsum;
        bf16_t* op = mix + (size_t)(qrow0 + qi) * DM + 256 + h * 64 + fq * 4;
#pragma unroll
        for (int dt = 0; dt < 4; ++dt) { uint2 ov; ov.x = pack2(o[dt][0] * inv, o[dt][1] * inv); ov.y = pack2(o[dt][2] * inv, o[dt][3] * inv); *(uint2*)(op + dt * 16) = ov; }
    }
}

__device__ void delta_out(const Params& p, int l, int item, char* lds) {
    const Item it = decode_item(item);
    const int cs = it.cs, h = it.h, t = tid_opaque(), lane = t & 63, w = t >> 6, fr = lane & 15, fq = lane >> 4;
    bf16_t* Rl = (bf16_t*)lds;
    float* Sl = (float*)(lds + 8448);
    const bf16_t* gR = (const bf16_t*)(p.ws + OFF_REG + R_DR) + (size_t)item * 4096;
    const bf16_t* gO = (const bf16_t*)(p.ws + OFF_REG + R_DO0) + (size_t)item * 4096;
    const float* gS = (const float*)(p.ws + OFF_REG + R_DS) + (size_t)item * 4096;
    const bf16_t* P = (const bf16_t*)(p.ws + OFF_REG + R_P);
    bf16_t* mix = (bf16_t*)(p.ws + OFF_REG + R_MIX);
    __syncthreads();
    for (int e = t; e < cs * 64; e += 256) Rl[(e >> 6) * 66 + (e & 63)] = gR[e];
    for (int e = t; e < 4096; e += 256) Sl[(e >> 6) * 65 + (e & 63)] = gS[e];
    __syncthreads();
    if (w * 16 < cs) {
        f32x4 acc[4]; float ss[4] = {0.f, 0.f, 0.f, 0.f};
#pragma unroll
        for (int vt = 0; vt < 4; ++vt) {
#pragma unroll
            for (int r = 0; r < 4; ++r) acc[vt][r] = bf2f(gO[(w * 16 + fq * 4 + r) * 64 + vt * 16 + fr]);
            acc[vt] = mm16(Rl + w * 16 * 66, 66, 1, Sl + vt * 16, 65, 1, 64, acc[vt], lane);
#pragma unroll
            for (int r = 0; r < 4; ++r) ss[r] += acc[vt][r] * acc[vt][r];
        }
#pragma unroll
        for (int r = 0; r < 4; ++r) {
            float s = ss[r];
            s += __shfl_xor(s, 1); s += __shfl_xor(s, 2); s += __shfl_xor(s, 4); s += __shfl_xor(s, 8);
            const float rs = rsqrtf(s * (1.f / 64.f) + EPSV);
            const int row = it.row0 + w * 16 + fq * 4 + r;
#pragma unroll
            for (int vt = 0; vt < 4; ++vt) {
                const int v = vt * 16 + fr;
                const float z = bf2f(P[(size_t)row * PC + C_ZC + h * 64 + v]);
                mix[(size_t)row * DM + 512 + h * 64 + v] = f2bf(acc[vt][r] * rs * p.delta_norm_g[l * 64 + v] * siluf(z));
            }
        }
    }
}
__device__ void gla_out(const Params& p, int l, int item, char* lds) {
    const Item it = decode_item(item);
    const int cs = it.cs, h = it.h, t = tid_opaque(), lane = t & 63, w = t >> 6, fr = lane & 15, fq = lane >> 4;
    bf16_t* Ql = (bf16_t*)lds;
    float* Sl = (float*)(lds + 4352);
    const bf16_t* gQ = (const bf16_t*)(p.ws + OFF_REG + R_GQ) + (size_t)item * 2048;
    const bf16_t* gO = (const bf16_t*)(p.ws + OFF_REG + R_GO0) + (size_t)item * 4096;
    const float* gS = (const float*)(p.ws + OFF_REG + R_GS) + (size_t)item * 2048;
    const bf16_t* P = (const bf16_t*)(p.ws + OFF_REG + R_P);
    bf16_t* mix = (bf16_t*)(p.ws + OFF_REG + R_MIX);
    __syncthreads();
    for (int e = t; e < cs * 32; e += 256) Ql[(e >> 5) * 34 + (e & 31)] = gQ[e];
    for (int e = t; e < 2048; e += 256) Sl[(e >> 6) * 65 + (e & 63)] = gS[e];
    __syncthreads();
    if (w * 16 < cs) {
        f32x4 acc[4]; float ss[4] = {0.f, 0.f, 0.f, 0.f};
#pragma unroll
        for (int vt = 0; vt < 4; ++vt) {
#pragma unroll
            for (int r = 0; r < 4; ++r) acc[vt][r] = bf2f(gO[(w * 16 + fq * 4 + r) * 64 + vt * 16 + fr]);
            acc[vt] = mm16(Ql + w * 16 * 34, 34, 1, Sl + vt * 16, 65, 1, 32, acc[vt], lane);
#pragma unroll
            for (int r = 0; r < 4; ++r) ss[r] += acc[vt][r] * acc[vt][r];
        }
#pragma unroll
        for (int r = 0; r < 4; ++r) {
            float s = ss[r];
            s += __shfl_xor(s, 1); s += __shfl_xor(s, 2); s += __shfl_xor(s, 4); s += __shfl_xor(s, 8);
            const float rs = rsqrtf(s * (1.f / 64.f) + EPSV);
            const int row = it.row0 + w * 16 + fq * 4 + r;
#pragma unroll
            for (int vt = 0; vt < 4; ++vt) {
                const int v = vt * 16 + fr;
                const float z = bf2f(P[(size_t)row * PC + C_GD + h * 64 + v]);
                mix[(size_t)row * DM + 768 + h * 64 + v] = f2bf(acc[vt][r] * rs * p.gla_norm_g[l * 64 + v] * siluf(z));
            }
        }
    }
}

__device__ void pool_item(const Params& p, int l, int item, char* lds) {
    const int tile = item >> 2, g = item & 3, win = 2 << g;
    const int t = tid_opaque(), lane = t & 63, w = t >> 6, fr = lane & 15, fq = lane >> 4;
    float* Wl = (float*)lds;
    float* U = (float*)(lds + 16640);
    float* Pl = (float*)(lds + 28672);
    const bf16_t* P = (const bf16_t*)(p.ws + OFF_REG + R_P);
    bf16_t* mix = (bf16_t*)(p.ws + OFF_REG + R_MIX);
    int b, t0, row0; bool sample;
    if (tile < 512) { b = tile >> 6; t0 = (tile & 63) * 32; row0 = b * 2048 + t0; sample = false; }
    else { b = tile - 512; t0 = 0; row0 = NPROMPT + b * 32; sample = true; }
    __syncthreads();
    for (int e = t; e < 4096; e += 256) Wl[(e >> 6) * 65 + (e & 63)] = p.pool_w[((size_t)(l * 4 + g) * 64) * 64 + e];
    for (int e = t; e < 47 * 64; e += 256) {
        const int r = e >> 6, ch = e & 63, tt = r - 15;
        float v;
        if (t0 + tt >= 0) v = bf2f(P[(size_t)(row0 + tt) * PC + C_UA + g * 64 + ch]);
        else v = sample ? p.cache_pool[((size_t)(l * 32 + b) * 15 + (15 + tt)) * 256 + g * 64 + ch] : 0.f;
        U[e] = v;
    }
    __syncthreads();
    for (int e = t; e < 32 * 64; e += 256) {
        const int tt = e >> 6, ch = e & 63;
        float s = 0.f;
        for (int j = 0; j < win; ++j) s += U[(15 + tt - j) * 64 + ch];
        const int pos1 = t0 + tt + 1;
        const float cnt = (sample || pos1 > win) ? (float)win : (float)pos1;
        Pl[tt * 65 + ch] = s / cnt - U[(15 + tt) * 64 + ch];
    }
    __syncthreads();
#pragma unroll
    for (int mt = 0; mt < 2; ++mt) {
        f32x4 z = (f32x4){0.f, 0.f, 0.f, 0.f};
        f32x4 y = mm16(Pl + mt * 16 * 65, 65, 1, Wl + w * 16, 65, 1, 64, z, lane);
        const int d = g * 64 + w * 16 + fr;
        const float sc = p.pool_scale[l * 256 + d];
#pragma unroll
        for (int r = 0; r < 4; ++r) mix[(size_t)(row0 + mt * 16 + fq * 4 + r) * DM + d] = f2bf(y[r] * sc);
    }
}

__device__ void copy_outs(const Params& p, int l) {
    const bf16_t* P = (const bf16_t*)(p.ws + OFF_REG + R_P);
    const size_t gt = (size_t)blockIdx.x * 256 + tid_opaque(), gs = (size_t)gridDim.x * 256;
    for (size_t e = gt; e < 2 * 1048576; e += gs) {
        const int kv = (int)(e >> 20), r = (int)(e & 1048575), d = r & 63, j = (r >> 6) & 511, h = (r >> 15) & 3, b = r >> 17;
        p.out[(kv ? O_VP : O_KP) + (size_t)l * 1048576 + r] = bf2f(P[(size_t)(b * 2048 + 1536 + j) * PC + (kv ? C_VB : C_KB) + h * 64 + d]);
    }
    for (size_t e = gt; e < 2 * 262144; e += gs) {
        const int kv = (int)(e >> 18), r = (int)(e & 262143), d = r & 63, j = (r >> 6) & 31, h = (r >> 11) & 3, b = r >> 13;
        p.out[(kv ? O_VS : O_KS) + (size_t)l * 262144 + r] = bf2f(P[(size_t)(NPROMPT + b * 32 + j) * PC + (kv ? C_VB : C_KB) + h * 64 + d]);
    }
    for (size_t e = gt; e < 40 * 3840; e += gs) {
        const int bb = (int)(e / 3840), r = (int)(e % 3840), rr = r >> 8, ch = r & 255;
        if (bb < 8) p.out[O_POOLP + (size_t)l * 30720 + e] = bf2f(P[(size_t)(bb * 2048 + 2033 + rr) * PC + C_UA + ch]);
        else p.out[O_POOLS + (size_t)l * 122880 + (e - 30720)] = bf2f(P[(size_t)(NPROMPT + (bb - 8) * 32 + 17 + rr) * PC + C_UA + ch]);
    }
    for (size_t e = gt; e < 40 * 2304; e += gs) {
        const int bb = (int)(e / 2304), r = (int)(e % 2304), rr = r / 768, ch = r % 768;
        if (bb < 8) p.out[O_CONVP + (size_t)l * 18432 + e] = bf2f(P[(size_t)(bb * 2048 + 2045 + rr) * PC + C_QC + ch]);
        else p.out[O_CONVS + (size_t)l * 73728 + (e - 18432)] = bf2f(P[(size_t)(NPROMPT + (bb - 8) * 32 + 29 + rr) * PC + C_QC + ch]);
    }
}

__device__ void final_rows(const Params& p, int it) {
    const int w = tid_opaque() >> 6, lane = tid_opaque() & 63, row = it * 4 + w;
    const float* xres = (const float*)(p.ws + OFF_XRES) + (size_t)row * DM;
    const f32x4* pp = (const f32x4*)((const float*)(p.ws + OFF_SSQ) + (size_t)row * 16);
    const f32x4 pa = (pp[0] + pp[1]) + (pp[2] + pp[3]);
    const float rs = rsqrtf(((pa[0] + pa[1]) + (pa[2] + pa[3])) * (1.f / DM) + EPSV);
    float* y = p.out + (size_t)row * DM;
#pragma unroll
    for (int i = 0; i < 4; ++i) {
        const int c = lane * 4 + 256 * i;
        float4 v = *(const float4*)(xres + c); const float4 g = *(const float4*)(p.final_norm_g + c);
        v.x *= rs * g.x; v.y *= rs * g.y; v.z *= rs * g.z; v.w *= rs * g.w;
        *(float4*)(y + c) = v;
    }
}

__device__ void run_phase(const Params& p, int ph, char* lds) {
    const int G = gridDim.x, B = blockIdx.x;
    if (ph == 0) {
        for (int it = B; it < CV_TOTAL + NTOK / 4; it += G) {
            if (it < CV_TOTAL) convert_layer_item(p, 0, it, lds); else prologue_rows(p, it - CV_TOTAL);
        }
        return;
    }
    if (ph == 1 + 7 * DEPTH) { for (int it = B; it < NTOK / 4; it += G) final_rows(p, it); return; }
    const int l = (ph - 1) / 7, sp = (ph - 1) % 7;
    const bf16_t* wb = (const bf16_t*)(p.ws + ((l & 1) ? OFF_WB1 : OFF_WB0));
    float* ssq = (float*)(p.ws + OFF_SSQ);
    bf16_t* xb = (bf16_t*)(p.ws + OFF_XB);
    float* xres = (float*)(p.ws + OFF_XRES);
    EpiP e{};
    if (sp == 0) {
        e.obf = (bf16_t*)(p.ws + OFF_REG + R_P); e.ldo = PC; e.ssq_in = ssq;
        for (int it = B; it < 136 * 23; it += G) gemm_tile<0>(xb, DM, wb + WB_IN, DM, it / 23, it % 23, e, lds);
    } else if (sp == 1) {
        for (int it = B; it < 2 * NITEM; it += G) { if (it < NITEM) delta_prep(p, l, it, lds); else gla_prep(p, l, it - NITEM, lds); }
    } else if (sp == 2) {
        for (int it = B; it < 128 + 256 + NITEM + 512 + 1024; it += G) {
            int i = it;
            if (i < 128) delta_scan(p, l, i, lds);
            else if ((i -= 128) < 256) gla_scan(p, l, i);
            else if ((i -= 256) < NITEM) attn_item(p, l, i, lds);
            else if ((i -= NITEM) < 512) delta_scan(p, l, 128 + i, lds);
            else gla_scan(p, l, 256 + (i - 512));
        }
    } else if (sp == 3) {
        const int ncv = (l + 1 < DEPTH) ? CV_TOTAL : 0;
        for (int it = B; it < 2 * NITEM + 2176 + ncv; it += G) {
            int i = it;
            if (i < NITEM) delta_out(p, l, i, lds);
            else if ((i -= NITEM) < NITEM) gla_out(p, l, i, lds);
            else if ((i -= NITEM) < 2176) pool_item(p, l, i, lds);
            else convert_layer_item(p, l + 1, i - 2176, lds);
        }
        copy_outs(p, l);
    } else if (sp == 4) {
        e.xres = xres; e.xb = xb; e.ssq_out = ssq;
        for (int it = B; it < 136 * 8; it += G) gemm_tile<1>((const bf16_t*)(p.ws + OFF_REG + R_MIX), DM, wb + WB_OUT, DM, it / 8, it % 8, e, lds);
    } else if (sp == 5) {
        e.obf = (bf16_t*)(p.ws + OFF_REG); e.ldo = DFF; e.ssq_in = ssq;
        for (int it = B; it < 136 * 32; it += G) gemm_tile<2>(xb, DM, wb + WB_UP, DM, it / 32, it % 32, e, lds);
    } else {
        e.xres = xres; e.xb = xb; e.ssq_out = ssq;
        for (int it = B; it < 136 * 8; it += G) gemm_tile<1>((const bf16_t*)(p.ws + OFF_REG), DFF, wb + WB_DN, DFF, it / 8, it % 8, e, lds);
    }
}

#define XB_TMO      128
#define XB_XCNT(j)  (256  + 64 * (j))
#define XB_XSUB(j)  (1280 + 64 * (j))
#define XB_XGEN(j)  (2304 + 64 * (j))
#define XB_TOP      3328
#define XB_TOPGEN   3392
#define XCD_BAR_WORDS 3456
#define XB_SPIN_CAP (1u << 22)
#define LAS __attribute__((address_space(3)))
__device__ __forceinline__ unsigned xb_ld(unsigned* p)              { return __hip_atomic_load(p, __ATOMIC_RELAXED, __HIP_MEMORY_SCOPE_AGENT); }
__device__ __forceinline__ unsigned xb_add(unsigned* p, unsigned v) { return __hip_atomic_fetch_add(p, v, __ATOMIC_RELAXED, __HIP_MEMORY_SCOPE_AGENT); }
__device__ __forceinline__ unsigned xb_xcc_id() { return (unsigned)__builtin_amdgcn_s_getreg((3 << 11) | 20) & 0xFu; }
#define XB_SPIN(cond, bar) do { unsigned _sp = 0; while (cond) { __builtin_amdgcn_s_sleep(1); \
    if ((++_sp & 255u) == 0u) { if (xb_ld(&(bar)[XB_TMO])) break; if (_sp > XB_SPIN_CAP) { atomicAdd(&(bar)[XB_TMO], 1u); break; } } } } while (0)
struct XcdBarrier { unsigned* bar; unsigned x; volatile LAS unsigned* st; };
__device__ __forceinline__ XcdBarrier xcd_barrier_post(unsigned* bar, volatile LAS unsigned* st) {
    XcdBarrier b; b.bar = bar; b.x = xb_xcc_id(); b.st = st;
    if (threadIdx.x == 0) (void)xb_add(&bar[XB_XCNT(b.x)], 1u);
    return b;
}
__device__ __forceinline__ void xcd_barrier_complete(unsigned* bar, unsigned x, unsigned& nloc, unsigned& nx) {
    const unsigned G = gridDim.x * gridDim.y * gridDim.z;
    unsigned sum, cnt, mine, sp = 0u;
    for (;;) {
        sum = 0u; cnt = 0u; mine = 0u;
#pragma unroll
        for (unsigned j = 0; j < 16; ++j) { const unsigned c = xb_ld(&bar[XB_XCNT(j)]); sum += c; cnt += (c > 0u) ? 1u : 0u; mine = (j == x) ? c : mine; }
        if (sum == G) break;
        __builtin_amdgcn_s_sleep(1);
        if ((++sp & 255u) == 0u) { if (xb_ld(&bar[XB_TMO])) break; if (sp > XB_SPIN_CAP) { atomicAdd(&bar[XB_TMO], 1u); break; } }
    }
    nloc = mine > 0u ? mine : 1u; nx = cnt > 0u ? cnt : 1u;
}
__device__ __forceinline__ void xcd_barrier(const XcdBarrier& b) {
    asm volatile("s_waitcnt vmcnt(0)" ::: "memory");
    __syncthreads();
    if (threadIdx.x == 0) {
        unsigned* bar = b.bar;
        __builtin_amdgcn_s_waitcnt(0);
        unsigned nloc = b.st[0], nx = b.st[1];
        if (nloc == 0u) { xcd_barrier_complete(bar, b.x, nloc, nx); b.st[0] = nloc; b.st[1] = nx; }
        const unsigned old = xb_add(&bar[XB_XSUB(b.x)], 1u);
        const unsigned gen = old / nloc;
        if (old + 1u == (gen + 1u) * nloc) {
            __builtin_amdgcn_fence(__ATOMIC_RELEASE, "agent");
            asm volatile("s_waitcnt vmcnt(0)" ::: "memory");
            const unsigned og = xb_add(&bar[XB_TOP], 1u);
            const unsigned tg = og / nx;
            if (og + 1u == (tg + 1u) * nx) xb_add(&bar[XB_TOPGEN], 1u);
            else XB_SPIN(xb_ld(&bar[XB_TOPGEN]) == tg, bar);
            __builtin_amdgcn_fence(__ATOMIC_ACQUIRE, "agent");
            xb_add(&bar[XB_XGEN(b.x)], 1u);
            asm volatile("s_waitcnt vmcnt(0)" ::: "memory");
        } else {
            XB_SPIN(xb_ld(&bar[XB_XGEN(b.x)]) == gen, bar);
            __builtin_amdgcn_fence(__ATOMIC_ACQUIRE, "agent");
            asm volatile("s_waitcnt vmcnt(0)" ::: "memory");
        }
    }
    __syncthreads();
}

constexpr int NPHASE = 2 + 7 * DEPTH;
constexpr unsigned PROBE_REP = 0x1111111u;

__global__ void __launch_bounds__(256, 2) mega(Params p) {
    extern __shared__ __attribute__((aligned(16))) char lds[];
    volatile LAS unsigned* st = (volatile LAS unsigned*)(lds + LDS_BYTES - 16);
    if (threadIdx.x == 0) { st[0] = 0u; st[1] = 0u; }
    __syncthreads();
    XcdBarrier xb = xcd_barrier_post(p.bar, st);
    for (int ph = p.ph_begin; ph < p.ph_end; ++ph) {
        const int sp_ = (ph >= 1 && ph <= 7 * DEPTH) ? (ph - 1) % 7 : -1;
        const int reps = sp_ < 0 ? 1 : ((PROBE_REP >> (4 * sp_)) & 15);
        for (int r = 0; r < reps; ++r) { run_phase(p, ph, lds); if (r + 1 < reps) xcd_barrier(xb); }
        if (ph + 1 < p.ph_end) { if (p.use_cg) cg::this_grid().sync(); else xcd_barrier(xb); }
    }
}

extern "C" void kernel_launch(void* const* d_in, const int* in_sizes, int n_in, void* d_out, int out_size, void* d_ws, size_t ws_size, hipStream_t stream) {
    static int grid_blocks = 0;
    if (!grid_blocks) {
        int dev = 0, cus = 0, per_cu = 0;
        hipGetDevice(&dev);
        hipDeviceGetAttribute(&cus, hipDeviceAttributeMultiprocessorCount, dev);
        hipFuncSetAttribute((const void*)mega, hipFuncAttributeMaxDynamicSharedMemorySize, LDS_BYTES);
        hipOccupancyMaxActiveBlocksPerMultiprocessor(&per_cu, mega, 256, LDS_BYTES);
        if (per_cu < 1) per_cu = 1;
        grid_blocks = cus * per_cu;
    }
    if (ws_size < WS_NEED) { fprintf(stderr, "workspace too small: %zu < %zu\n", ws_size, (size_t)WS_NEED); return; }
    Params p{};
    const float** f = (const float**)&p;
    for (int i = 0; i < 25; ++i) f[i] = (const float*)d_in[i];
    p.out = (float*)d_out; p.ws = (char*)d_ws; p.bar = (unsigned*)((char*)d_ws + OFF_BAR); p.use_cg = 0; p.pad0 = 0;
    hipMemsetAsync(p.bar, 0, XCD_BAR_WORDS * 4, stream);
#if ONE_LAUNCH
    p.ph_begin = 0; p.ph_end = NPHASE;
    void* args[] = {&p};
    hipError_t e = hipLaunchCooperativeKernel((void*)mega, dim3(grid_blocks), dim3(256), args, LDS_BYTES, stream);
    if (e != hipSuccess) fprintf(stderr, "cooperative launch failed: %s (grid %d)\n", hipGetErrorString(e), grid_blocks);
#else
    for (int ph = 0; ph < NPHASE; ++ph) {
        p.ph_begin = ph; p.ph_end = ph + 1;
        hipLaunchKernelGGL(mega, dim3(grid_blocks), dim3(256), LDS_BYTES, stream, p);
    }
#endif
}
```

```cpp
#include <hip/hip_runtime.h>
#include <hip/hip_cooperative_groups.h>
#include <cstdio>
#include <cstdint>
namespace cg = cooperative_groups;

#ifndef ONE_LAUNCH
#define ONE_LAUNCH 1
#endif

typedef unsigned short bf16_t;
typedef short bf16x8 __attribute__((ext_vector_type(8)));
typedef float f32x4 __attribute__((ext_vector_type(4)));
typedef unsigned u32x4 __attribute__((ext_vector_type(4)));

constexpr int DM = 1024, NTOK = 17408, NPROMPT = 16384, PC = 3072, INC = 2840, DFF = 4096, DEPTH = 4;
constexpr int C_UA = 0, C_QB = 256, C_KB = 512, C_VB = 768, C_QC = 1024, C_ZC = 1792, C_AC = 2048, C_BC = 2052,
              C_QD = 2056, C_KD = 2184, C_VD = 2312, C_GD = 2568, C_GK = 2824;
constexpr int NITEM = 1152;
constexpr float EPSV = 1e-6f;
constexpr int HALF_LDS = 77824, LDS_BYTES = 2 * HALF_LDS;

constexpr size_t WB_IN = 0, WB_OUT = (size_t)PC * DM, WB_UP = WB_OUT + (size_t)DM * DM, WB_DN = WB_UP + (size_t)DFF * DM,
                 WB_ELEMS = WB_DN + (size_t)DM * DFF;
constexpr size_t OFF_WB0 = 0, OFF_WB1 = WB_ELEMS * 2, OFF_XRES = OFF_WB1 + WB_ELEMS * 2, OFF_XB = OFF_XRES + (size_t)NTOK * DM * 4,
                 OFF_SSQ = OFF_XB + (size_t)NTOK * DM * 2, OFF_REG = OFF_SSQ + (size_t)16 * NTOK * 4;
constexpr size_t R_P = 0, R_MIX = R_P + (size_t)NTOK * PC * 2, R_DM = R_MIX + (size_t)NTOK * DM * 2, R_DN = R_DM + (size_t)NITEM * 16384,
                 R_DR = R_DN + (size_t)NITEM * 16384, R_DO0 = R_DR + (size_t)NITEM * 8192, R_DS = R_DO0 + (size_t)NITEM * 8192,
                 R_GN = R_DS + (size_t)NITEM * 16384, R_GQ = R_GN + (size_t)NITEM * 8192, R_GO0 = R_GQ + (size_t)NITEM * 4096,
                 R_GD = R_GO0 + (size_t)NITEM * 8192, R_GS = R_GD + (size_t)NITEM * 128, R_END = R_GS + (size_t)NITEM * 8192;
constexpr size_t OFF_BAR = OFF_REG + R_END;
constexpr size_t WS_NEED = OFF_BAR + 16384;
static_assert(WS_NEED <= 419197120, "workspace");
static_assert((size_t)NTOK * DFF * 2 <= R_END, "up overlay");
constexpr size_t O_YP = 0, O_YS = 16777216, O_POOLP = O_YS + 1048576, O_KP = O_POOLP + 122880, O_VP = O_KP + 4194304, O_CONVP = O_VP + 4194304,
                 O_DELTAP = O_CONVP + 73728, O_GLAP = O_DELTAP + 524288, O_POOLS = O_GLAP + 262144, O_KS = O_POOLS + 491520, O_VS = O_KS + 1048576,
                 O_CONVS = O_VS + 1048576, O_DELTAS = O_CONVS + 294912, O_GLAS = O_DELTAS + 2097152;

struct Params {
    const float *x_prompt, *x_sample, *cache_pool, *cache_k, *cache_v, *state_conv, *state_delta, *state_gla;
    const float *attn_norm_g, *w_in, *pool_w, *pool_scale, *rel_bias, *conv_w, *a_log, *dt_bias, *delta_norm_g, *gla_w_gk, *gla_b_gk,
        *gla_norm_g, *w_out, *mlp_norm_g, *w_up, *w_down, *final_norm_g;
    float* out;
    char* ws;
    unsigned* bar;
    int ph_begin, ph_end, use_cg, pad0;
};

__device__ __forceinline__ float bf2f(bf16_t v) { return __uint_as_float(((unsigned)v) << 16); }
__device__ __forceinline__ bf16_t f2bf(float f) { unsigned u = __float_as_uint(f); u += 0x7fffu + ((u >> 16) & 1u); return (bf16_t)(u >> 16); }
__device__ __forceinline__ unsigned pack2(float lo, float hi) { return (unsigned)f2bf(lo) | ((unsigned)f2bf(hi) << 16); }
__device__ __forceinline__ float ldf(const float* p) { return *p; }
__device__ __forceinline__ float ldf(const bf16_t* p) { return bf2f(*p); }
__device__ __forceinline__ float wave_sum(float v) {
#pragma unroll
    for (int o = 32; o; o >>= 1) v += __shfl_xor(v, o);
    return v;
}
__device__ __forceinline__ float siluf(float x) { return x / (1.f + expf(-x)); }

template <typename TA, typename TB>
__device__ __forceinline__ f32x4 mm16(const TA* A, int a_rs, int a_cs, const TB* B, int b_rs, int b_cs, int K, f32x4 acc, int lane) {
    const int i = lane & 15, kq = lane >> 4;
    const TA* ap = A + i * a_rs + kq * a_cs;
    const TB* bp = B + kq * b_rs + i * b_cs;
    for (int k0 = 0; k0 < K; k0 += 32) {
        float a[8], b[8];
#pragma unroll
        for (int u = 0; u < 8; ++u) { a[u] = ldf(ap + (k0 + 4 * u) * a_cs); b[u] = ldf(bp + (k0 + 4 * u) * b_rs); }
#pragma unroll
        for (int u = 0; u < 8; ++u) acc = __builtin_amdgcn_mfma_f32_16x16x4f32(a[u], b[u], acc, 0, 0, 0);
    }
    return acc;
}
template <typename TA, typename TB>
__device__ __forceinline__ f32x4 mm16s(const TA* A, int a_rs, int a_cs, const TB* B, int b_rs, int b_cs, int K, f32x4 acc, int lane) {
    const int i = lane & 15, kq = lane >> 4;
    const TA* ap = A + i * a_rs + kq * a_cs;
    const TB* bp = B + kq * b_rs + i * b_cs;
    for (int k0 = 0; k0 < K; k0 += 16) {
        float a[4], b[4];
#pragma unroll
        for (int u = 0; u < 4; ++u) { a[u] = ldf(ap + (k0 + 4 * u) * a_cs); b[u] = ldf(bp + (k0 + 4 * u) * b_rs); }
#pragma unroll
        for (int u = 0; u < 4; ++u) acc = __builtin_amdgcn_mfma_f32_16x16x4f32(a[u], b[u], acc, 0, 0, 0);
    }
    return acc;
}

__device__ __forceinline__ int tid_opaque() { int t = threadIdx.x & 255; asm volatile("" : "+v"(t)); return t; }
__device__ __forceinline__ const float* xin_row(const Params& p, int row) {
    return row < NPROMPT ? p.x_prompt + (size_t)row * DM : p.x_sample + (size_t)(row - NPROMPT) * DM;
}

__device__ void convert_tile(const float* __restrict__ src, bf16_t* __restrict__ dst, int K, int N, const float* __restrict__ g, int tile, char* lds) {
    float* T = (float*)lds;
    const int nkt = K >> 6, kt = tile % nkt, nt = tile / nkt, t = tid_opaque();
    __syncthreads();
#pragma unroll
    for (int i = 0; i < 4; ++i) {
        const int kl = (t >> 4) + 16 * i, k = kt * 64 + kl, nl = (t & 15) * 4, n0 = nt * 64 + nl;
        float4 v = make_float4(0.f, 0.f, 0.f, 0.f);
        if (n0 < N) v = *(const float4*)(src + (size_t)k * N + n0);
        if (g) { const float s = g[k]; v.x *= s; v.y *= s; v.z *= s; v.w *= s; }
        T[(nl + 0) * 65 + kl] = v.x; T[(nl + 1) * 65 + kl] = v.y; T[(nl + 2) * 65 + kl] = v.z; T[(nl + 3) * 65 + kl] = v.w;
    }
    __syncthreads();
    const int n = t >> 2, kc = (t & 3) * 16;
    const float* r = T + n * 65 + kc;
    uint4 a, b;
    a.x = pack2(r[0], r[1]); a.y = pack2(r[2], r[3]); a.z = pack2(r[4], r[5]); a.w = pack2(r[6], r[7]);
    b.x = pack2(r[8], r[9]); b.y = pack2(r[10], r[11]); b.z = pack2(r[12], r[13]); b.w = pack2(r[14], r[15]);
    bf16_t* d = dst + (size_t)(nt * 64 + n) * K + kt * 64 + kc;
    *(uint4*)d = a; *(uint4*)(d + 8) = b;
}
constexpr int CV_IN = 16 * 48, CV_OUT = 16 * 16, CV_UP = 16 * 64, CV_DN = 64 * 16, CV_TOTAL = CV_IN + CV_OUT + CV_UP + CV_DN;
__device__ void convert_layer_item(const Params& p, int l, int it, char* lds) {
    bf16_t* wb = (bf16_t*)(p.ws + ((l & 1) ? OFF_WB1 : OFF_WB0));
    if (it < CV_IN) convert_tile(p.w_in + (size_t)l * DM * INC, wb + WB_IN, DM, INC, p.attn_norm_g + l * DM, it, lds);
    else if ((it -= CV_IN) < CV_OUT) convert_tile(p.w_out + (size_t)l * DM * DM, wb + WB_OUT, DM, DM, nullptr, it, lds);
    else if ((it -= CV_OUT) < CV_UP) convert_tile(p.w_up + (size_t)l * DM * DFF, wb + WB_UP, DM, DFF, p.mlp_norm_g + l * DM, it, lds);
    else { it -= CV_UP; convert_tile(p.w_down + (size_t)l * DFF * DM, wb + WB_DN, DFF, DM, nullptr, it, lds); }
}

__device__ void prologue_rows(const Params& p, int it) {
    const int w = tid_opaque() >> 6, lane = tid_opaque() & 63, row = it * 4 + w;
    const float* x = xin_row(p, row);
    float* xres = (float*)(p.ws + OFF_XRES) + (size_t)row * DM;
    bf16_t* xb = (bf16_t*)(p.ws + OFF_XB) + (size_t)row * DM;
    float* ssq = (float*)(p.ws + OFF_SSQ);
    float s = 0.f;
#pragma unroll
    for (int i = 0; i < 4; ++i) {
        const int c = lane * 4 + 256 * i;
        float4 v = *(const float4*)(x + c);
        s += v.x * v.x + v.y * v.y + v.z * v.z + v.w * v.w;
        *(float4*)(xres + c) = v;
        uint2 o; o.x = pack2(v.x, v.y); o.y = pack2(v.z, v.w);
        *(uint2*)(xb + c) = o;
    }
    s = wave_sum(s);
    if (lane < 16) ssq[(size_t)row * 16 + lane] = lane == 0 ? s : 0.f;
}

namespace pg8 {
#define PG8_LAS __attribute__((address_space(3)))
typedef unsigned short bf16_t;
typedef short bf16x8 __attribute__((ext_vector_type(8)));
typedef float f32x4 __attribute__((ext_vector_type(4)));
typedef unsigned u32x4 __attribute__((ext_vector_type(4)));
constexpr int BM = 256, BK = 64, HALF = 128, HTB = HALF * BK * 2  , STAGE_BYTES = 8 * HTB, NXCD = 8, WGM = 8;

__host__ __device__ __forceinline__ int lds_byte(int r, int c) { const int st = (r >> 4) * 2 + (c >> 5), rr = r & 15, cc = c & 31, ob = rr * 64 + cc * 2; return st * 1024 + (ob ^ (((ob >> 9) & 1) << 5)); }
__host__ __device__ __forceinline__ void stage_rc(int b, int& R, int& C) { const int st = b / 1024, sb = b % 1024, swz = sb ^ (((sb >> 9) & 1) << 5); R = (st >> 1) * 16 + swz / 64; C = (st & 1) * 32 + (swz % 64) / 2; }
__host__ __device__ __forceinline__ int perm32(int rho) { const int n = rho >> 4, i = rho & 15; return 8 * (i >> 2) + 4 * n + (i & 3); }

struct Unit { int pm, pn; };
struct Gemm { const bf16_t* A; const bf16_t* Bt; int M, N, K; };

struct StaticOrder {
    int nM, nN, nwg, G, c;
    __host__ __device__ void init(int M, int N, int G_, int c_) { nM = M / BM; nN = N / BM; nwg = nM * nN; G = G_; c = c_; }
    __host__ __device__ bool next(int i, Unit& u) const {
        const long L = (long)i * G + c; if (L >= nwg) return false;
        int wgid = (int)L; { const int q = nwg / NXCD, r = nwg % NXCD, xcd = wgid % NXCD, off = wgid / NXCD; wgid = (xcd < r ? xcd * (q + 1) : r * (q + 1) + (xcd - r) * q) + off; }
        const int nig = WGM * nN, gid = wgid / nig, fm = gid * WGM, gsz = (nM - fm) < WGM ? (nM - fm) : WGM;
        u.pm = fm + ((wgid % nig) % gsz); u.pn = (wgid % nig) / gsz; return true;
    }
    __device__ __forceinline__ void a_ready(const Unit&) const {}
    __device__ __forceinline__ void done(const Unit&) const {}
};
__device__ __forceinline__ unsigned cvt_pk_bf16(float lo, float hi) { unsigned r; asm volatile("v_cvt_pk_bf16_f32 %0, %1, %2" : "=v"(r) : "v"(lo), "v"(hi)); return r; }
template <class Epi, class Sched, bool ALIGN_EPI = false, bool SP2 = false>
__device__ __forceinline__ void gemm_phase(PG8_LAS unsigned char* lds, const Gemm g, const Sched& S, const Epi& E) {
    int tid_ = threadIdx.x; asm volatile("" : "+v"(tid_));
    const int tid = tid_, wid = __builtin_amdgcn_readfirstlane(tid >> 6), lane = tid & 63, wr = wid >> 2, wc = wid & 3, fr = lane & 15, fq = lane >> 4;
    const int K = g.K, nt = K / BK;
    unsigned voffA[2], voffB[2];
#pragma unroll
    for (int i = 0; i < 2; ++i) { int R, C; stage_rc(tid * 16 + i * 8192, R, C); const int Rb = Epi::PERM ? ((R & ~31) + perm32(R & 31)) : R;
        voffA[i] = (unsigned)(R * K + C) * 2u; voffB[i] = (unsigned)(Rb * K + C) * 2u; }
    const size_t kstep = (size_t)(BK * 2);
    const size_t hstep = (size_t)HALF * K * 2;
    const size_t tstep = 2 * hstep;
    const unsigned ldsw = (unsigned)wid * 1024u;
    const int aoff = lds_byte(wr * 64 + fr, fq * 8), boff = lds_byte(wc * 32 + fr, fq * 8);
#define PG8_SA(b, h) (((b) * 2 + (h)) * HTB)
#define PG8_SB(b, h) ((4 + (b) * 2 + (h)) * HTB)
#define PG8_STAGE(bufoff, gbase, voff) do { _Pragma("unroll") for (int _i = 0; _i < 2; ++_i) \
        __builtin_amdgcn_global_load_lds((const unsigned*)((const char*)(gbase) + (voff)[_i]), (PG8_LAS unsigned*)(lds + (bufoff) + ldsw + _i * 8192), 16, 0, 0); } while (0)
#define PG8_LDA(dst, b, h) do { _Pragma("unroll") for (int m = 0; m < 4; ++m) _Pragma("unroll") for (int k = 0; k < 2; ++k) dst[m][k] = *(const PG8_LAS bf16x8*)(lds + PG8_SA(b, h) + aoff + m * 2048 + k * 1024); } while (0)
#define PG8_LDB(dst, b, h) do { _Pragma("unroll") for (int n = 0; n < 2; ++n) _Pragma("unroll") for (int k = 0; k < 2; ++k) dst[n][k] = *(const PG8_LAS bf16x8*)(lds + PG8_SB(b, h) + boff + n * 2048 + k * 1024); } while (0)
#define PG8_MMA(ai, bj, At, Bt) do { __builtin_amdgcn_s_setprio(1); _Pragma("unroll") for (int m = 0; m < 4; ++m) _Pragma("unroll") for (int n = 0; n < 2; ++n) _Pragma("unroll") for (int k = 0; k < 2; ++k) \
        acc[ai][bj][m][n] = __builtin_amdgcn_mfma_f32_16x16x32_bf16(Bt[n][k], At[m][k], acc[ai][bj][m][n], 0, 0, 0); __builtin_amdgcn_s_setprio(0); } while (0)
#define PG8_WAIT_V(n) asm volatile("s_waitcnt vmcnt(" #n ")" ::: "memory")
#define PG8_WAIT_L(n) asm volatile("s_waitcnt lgkmcnt(" #n ")" ::: "memory")
#define PG8_BAR __builtin_amdgcn_s_barrier()
#define PG8_SCHED __builtin_amdgcn_sched_barrier(0)
    Unit cur, nxt; int ui = 0;
    if (!S.next(0, cur)) return;
    f32x4 acc[2][2][4][2];
#pragma unroll
    for (int a = 0; a < 2; ++a)
#pragma unroll
        for (int b = 0; b < 2; ++b)
#pragma unroll
            for (int m = 0; m < 4; ++m)
#pragma unroll
                for (int n = 0; n < 2; ++n) acc[a][b][m][n] = (f32x4){0.f, 0.f, 0.f, 0.f};
    bf16x8 At[4][2], B0[2][2], B1[2][2];
    const char* cA = (const char*)g.A + (size_t)cur.pm * tstep; const char* cB = (const char*)g.Bt + (size_t)cur.pn * tstep;
    S.a_ready(cur);
    if constexpr (SP2) {
        PG8_STAGE(PG8_SB(0, 0), cB, voffB); PG8_STAGE(PG8_SB(0, 1), cB + hstep, voffB); PG8_STAGE(PG8_SA(0, 0), cA, voffA); PG8_STAGE(PG8_SA(0, 1), cA + hstep, voffA);
        if (wr == 1) PG8_BAR;
        PG8_WAIT_V(2); PG8_BAR;
        PG8_STAGE(PG8_SB(1, 0), cB + kstep, voffB); PG8_STAGE(PG8_SA(1, 0), cA + kstep, voffA); PG8_STAGE(PG8_SB(1, 1), cB + hstep + kstep, voffB);
        PG8_WAIT_V(6); PG8_BAR;
    } else {
        PG8_STAGE(PG8_SB(0, 0), cB, voffB); PG8_STAGE(PG8_SA(0, 0), cA, voffA); PG8_STAGE(PG8_SB(0, 1), cB + hstep, voffB); PG8_STAGE(PG8_SA(0, 1), cA + hstep, voffA);
        if (wr == 1) PG8_BAR;
        PG8_WAIT_V(4); PG8_BAR;
        PG8_STAGE(PG8_SB(1, 0), cB + kstep, voffB); PG8_STAGE(PG8_SA(1, 0), cA + kstep, voffA); PG8_STAGE(PG8_SB(1, 1), cB + hstep + kstep, voffB);
        PG8_WAIT_V(6); PG8_BAR;
    }
    for (;;) {
        const bool has_next = S.next(ui + 1, nxt);
        const char* nA = has_next ? (const char*)g.A + (size_t)nxt.pm * tstep : cA; const char* nB = has_next ? (const char*)g.Bt + (size_t)nxt.pn * tstep : cB;
        for (int t = 0; t < nt; t += 2) {
            const bool last = (t == nt - 2);
            const char* a1 = cA + (size_t)(t + 1) * kstep;
            const char* a2 = last ? nA : cA + (size_t)(t + 2) * kstep; const char* b2 = last ? nB : cB + (size_t)(t + 2) * kstep;
            const char* a3 = a2 + kstep; const char* b3 = b2 + kstep;
            if (last && has_next) S.a_ready(nxt);
            if constexpr (SP2) {
            PG8_LDB(B0, 0, 0); PG8_LDB(B1, 0, 1); PG8_SCHED; PG8_LDA(At, 0, 0); PG8_STAGE(PG8_SA(1, 1), a1 + hstep, voffA);
            PG8_WAIT_V(8); PG8_WAIT_L(0); PG8_BAR; PG8_MMA(0, 0, At, B0); PG8_MMA(0, 1, At, B1); PG8_BAR; PG8_SCHED;
            PG8_LDA(At, 0, 1); PG8_STAGE(PG8_SB(0, 0), b2, voffB); PG8_STAGE(PG8_SB(0, 1), b2 + hstep, voffB); PG8_STAGE(PG8_SA(0, 0), a2, voffA);
            PG8_WAIT_V(8); PG8_WAIT_L(0); PG8_BAR; PG8_MMA(1, 0, At, B0); PG8_MMA(1, 1, At, B1); PG8_BAR; PG8_SCHED;
            PG8_LDB(B0, 1, 0); PG8_LDB(B1, 1, 1); PG8_SCHED; PG8_LDA(At, 1, 0); PG8_STAGE(PG8_SA(0, 1), a2 + hstep, voffA);
            PG8_WAIT_V(8); PG8_WAIT_L(0); PG8_BAR; PG8_MMA(0, 0, At, B0); PG8_MMA(0, 1, At, B1); PG8_BAR; PG8_SCHED;
            PG8_LDA(At, 1, 1); PG8_STAGE(PG8_SB(1, 0), b3, voffB); PG8_STAGE(PG8_SB(1, 1), b3 + hstep, voffB); PG8_STAGE(PG8_SA(1, 0), a3, voffA);
            PG8_WAIT_V(8); PG8_WAIT_L(0); PG8_BAR; PG8_MMA(1, 0, At, B0); PG8_MMA(1, 1, At, B1); PG8_BAR; PG8_SCHED;
            } else {
            PG8_LDB(B0, 0, 0); PG8_SCHED; PG8_LDA(At, 0, 0); PG8_STAGE(PG8_SA(1, 1), a1 + hstep, voffA);
            PG8_WAIT_L(8); PG8_BAR; PG8_WAIT_L(0); PG8_MMA(0, 0, At, B0); PG8_BAR; PG8_SCHED;
            PG8_LDB(B1, 0, 1); PG8_STAGE(PG8_SB(0, 0), b2, voffB);
            PG8_BAR; PG8_WAIT_L(0); PG8_MMA(0, 1, At, B1); PG8_BAR;
            PG8_LDA(At, 0, 1); PG8_STAGE(PG8_SA(0, 0), a2, voffA);
            PG8_BAR; PG8_WAIT_L(0); PG8_MMA(1, 0, At, B0); PG8_BAR; PG8_SCHED;
            PG8_STAGE(PG8_SB(0, 1), b2 + hstep, voffB);
            PG8_WAIT_V(6); PG8_BAR; PG8_MMA(1, 1, At, B1); PG8_BAR;
            PG8_LDB(B0, 1, 0); PG8_SCHED; PG8_LDA(At, 1, 0); PG8_STAGE(PG8_SA(0, 1), a2 + hstep, voffA);
            PG8_WAIT_L(8); PG8_BAR; PG8_WAIT_L(0); PG8_MMA(0, 0, At, B0); PG8_BAR; PG8_SCHED;
            PG8_LDB(B1, 1, 1); PG8_STAGE(PG8_SB(1, 0), b3, voffB);
            PG8_BAR; PG8_WAIT_L(0); PG8_MMA(0, 1, At, B1); PG8_BAR;
            PG8_LDA(At, 1, 1); PG8_STAGE(PG8_SA(1, 0), a3, voffA);
            PG8_BAR; PG8_WAIT_L(0); PG8_MMA(1, 0, At, B0); PG8_BAR; PG8_SCHED;
            PG8_STAGE(PG8_SB(1, 1), b3 + hstep, voffB);
            PG8_WAIT_V(6); PG8_BAR; PG8_MMA(1, 1, At, B1); PG8_BAR;
            }
        }
        if constexpr (ALIGN_EPI) { if (wr == 0) PG8_BAR; }
        if constexpr (!Epi::AFTER_DRAIN) { E(acc, cur, wr, wc, fr, fq); S.done(cur); }
        if (!has_next) break;
#pragma unroll
        for (int a = 0; a < 2; ++a)
#pragma unroll
            for (int b = 0; b < 2; ++b)
#pragma unroll
                for (int m = 0; m < 4; ++m)
#pragma unroll
                    for (int n = 0; n < 2; ++n) acc[a][b][m][n] = (f32x4){0.f, 0.f, 0.f, 0.f};
        cur = nxt; cA = nA; cB = nB; ++ui;
        if constexpr (ALIGN_EPI) { if (wr == 1) PG8_BAR; }
    }
    PG8_WAIT_V(0);
    if constexpr (!ALIGN_EPI) { if (wr == 0) PG8_BAR; }
    PG8_BAR;
    if constexpr (Epi::AFTER_DRAIN) { E.fused(acc, cur, wr, wc, fr, fq, lds, wid, lane); S.done(cur); }
#undef PG8_SA
#undef PG8_SB
#undef PG8_STAGE
#undef PG8_LDA
#undef PG8_LDB
#undef PG8_MMA
#undef PG8_WAIT_V
#undef PG8_WAIT_L
#undef PG8_BAR
#undef PG8_SCHED
}
}

__device__ __forceinline__ float row_rstd(const float* ssq, int row) {
    const f32x4* pp = (const f32x4*)(ssq + (size_t)row * 16);
    const f32x4 a = (pp[0] + pp[1]) + (pp[2] + pp[3]);
    return rsqrtf(((a[0] + a[1]) + (a[2] + a[3])) * (1.f / DM) + EPSV);
}
template <int ACT> struct EpiNorm {
    static constexpr bool PERM = true, AFTER_DRAIN = false;
    bf16_t* O; int ldc; const float* ssq;
    __device__ __forceinline__ void operator()(const f32x4 (&acc)[2][2][4][2], const pg8::Unit& u, int wr, int wc, int fr, int fq) const {
        const int row0 = u.pm * 256 + wr * 64 + fr, col0 = u.pn * 256 + wc * 32 + 8 * fq;
#pragma unroll
        for (int ai = 0; ai < 2; ++ai)
#pragma unroll
            for (int m = 0; m < 4; ++m) {
                const int row = row0 + ai * 128 + m * 16;
                const float rs = row_rstd(ssq, row);
                bf16_t* rowp = O + (size_t)row * ldc + col0;
#pragma unroll
                for (int bj = 0; bj < 2; ++bj) {
                    f32x4 v0 = acc[ai][bj][m][0] * rs, v1 = acc[ai][bj][m][1] * rs;
                    if (ACT == 1) {
#pragma unroll
                        for (int q = 0; q < 4; ++q) { const float a = fmaxf(v0[q], 0.f), b = fmaxf(v1[q], 0.f); v0[q] = a * a; v1[q] = b * b; }
                    }
                    u32x4 o; o[0] = pg8::cvt_pk_bf16(v0[0], v0[1]); o[1] = pg8::cvt_pk_bf16(v0[2], v0[3]); o[2] = pg8::cvt_pk_bf16(v1[0], v1[1]); o[3] = pg8::cvt_pk_bf16(v1[2], v1[3]);
                    *(u32x4*)(rowp + bj * 128) = o;
                }
            }
    }
};
struct EpiRes {
    static constexpr bool PERM = true, AFTER_DRAIN = false;
    float* xres; bf16_t* xb; float* ssq;
    __device__ __forceinline__ void operator()(const f32x4 (&acc)[2][2][4][2], const pg8::Unit& u, int wr, int wc, int fr, int fq) const {
        const int row0 = u.pm * 256 + wr * 64 + fr, col0 = u.pn * 256 + wc * 32 + 8 * fq;
#pragma unroll
        for (int ai = 0; ai < 2; ++ai)
#pragma unroll
            for (int m = 0; m < 4; ++m) {
                const int row = row0 + ai * 128 + m * 16;
                float sq = 0.f;
#pragma unroll
                for (int bj = 0; bj < 2; ++bj) {
                    float* xp = xres + (size_t)row * DM + col0 + bj * 128;
                    const f32x4 x0 = *(const f32x4*)xp + acc[ai][bj][m][0], x1 = *(const f32x4*)(xp + 4) + acc[ai][bj][m][1];
                    *(f32x4*)xp = x0; *(f32x4*)(xp + 4) = x1;
                    u32x4 o; o[0] = pg8::cvt_pk_bf16(x0[0], x0[1]); o[1] = pg8::cvt_pk_bf16(x0[2], x0[3]); o[2] = pg8::cvt_pk_bf16(x1[0], x1[1]); o[3] = pg8::cvt_pk_bf16(x1[2], x1[3]);
                    *(u32x4*)(xb + (size_t)row * DM + col0 + bj * 128) = o;
                    sq += (x0[0] * x0[0] + x0[1] * x0[1]) + (x0[2] * x0[2] + x0[3] * x0[3]) + (x1[0] * x1[0] + x1[1] * x1[1]) + (x1[2] * x1[2] + x1[3] * x1[3]);
                }
                sq += __shfl_xor(sq, 16); sq += __shfl_xor(sq, 32);
                if (fq == 0) ssq[(size_t)row * 16 + u.pn * 4 + wc] = sq;
            }
    }
};
template <class Epi>
__device__ __forceinline__ void gemm_run(char* lds, const bf16_t* A, const bf16_t* Bt, int N, int K, const Epi& E) {
    pg8::Gemm g; g.A = A; g.Bt = Bt; g.M = NTOK; g.N = N; g.K = K;
    pg8::StaticOrder S; S.init(NTOK, N, gridDim.x, blockIdx.x);
    pg8::gemm_phase<Epi, pg8::StaticOrder, true, true>((PG8_LAS unsigned char*)lds, g, S, E);
}

struct Item { int b, h, c, cs, row0; bool sample; };
__device__ __forceinline__ Item decode_item(int item) {
    Item r;
    if (item < 1024) { r.b = item >> 7; r.h = (item >> 5) & 3; r.c = item & 31; r.cs = 64; r.row0 = r.b * 2048 + r.c * 64; r.sample = false; }
    else { const int s = item - 1024; r.b = s >> 2; r.h = s & 3; r.c = 0; r.cs = 32; r.row0 = NPROMPT + r.b * 32; r.sample = true; }
    return r;
}

__device__ void delta_prep(const Params& p, int l, int item, char* lds) {
    const Item it = decode_item(item);
    const int cs = it.cs, h = it.h, t = tid_opaque(), lane = t & 63, w = t >> 6, fr = lane & 15, fq = lane >> 4;
    float* Ks = (float*)lds;
    float* X = (float*)(lds + 16640);
    float* Am = (float*)(lds + 49664);
    bf16_t* QKm = (bf16_t*)(lds + 66304);
    float* Gs = (float*)(lds + 74752);
    float* Bs = (float*)(lds + 75008);
    const bf16_t* P = (const bf16_t*)(p.ws + OFF_REG + R_P);
    const float* cw = p.conv_w + (size_t)l * 4 * 768;
    const float* hist = p.state_conv + (size_t)(l * 32 + it.b) * 3 * 768;
    bf16_t* Raw = (bf16_t*)(lds + 49664);
    __syncthreads();
    for (int e = t; e < (cs + 3) * 24; e += 256) {
        const int r = e / 24, ci = e - r * 24, which = ci >> 3, d0 = (ci & 7) * 8, tt = r - 3, cwi = which * 256 + h * 64 + d0;
        u32x4 v = (u32x4){0u, 0u, 0u, 0u};
        if (tt >= 0 || (!it.sample && it.c > 0)) v = *(const u32x4*)(P + (size_t)(it.row0 + tt) * PC + C_QC + cwi);
        else if (it.sample) {
            const float4 a = *(const float4*)(hist + (3 + tt) * 768 + cwi), b = *(const float4*)(hist + (3 + tt) * 768 + cwi + 4);
            v[0] = pack2(a.x, a.y); v[1] = pack2(a.z, a.w); v[2] = pack2(b.x, b.y); v[3] = pack2(b.z, b.w);
        }
        *(u32x4*)(Raw + r * 192 + ci * 8) = v;
    }
    __syncthreads();
    for (int e = t; e < cs * 192; e += 256) {
        const int tok = e / 192, ch = e - tok * 192, which = ch >> 6, d = ch & 63, cwi = which * 256 + h * 64 + d;
        float acc = 0.f;
#pragma unroll
        for (int j = 0; j < 4; ++j) acc += bf2f(Raw[(tok + j) * 192 + ch]) * cw[j * 768 + cwi];
        const float cv = siluf(acc);
        if (which == 0) X[tok * 129 + 64 + d] = cv; else if (which == 1) Ks[tok * 65 + d] = cv; else X[tok * 129 + d] = cv;
    }
    __syncthreads();
    for (int tok = w; tok < cs; tok += 4) {
        const float kv = Ks[tok * 65 + lane], qv = X[tok * 129 + 64 + lane];
        const float sk = wave_sum(kv * kv), sq = wave_sum(qv * qv);
        Ks[tok * 65 + lane] = kv * rsqrtf(sk + EPSV);
        X[tok * 129 + 64 + lane] = qv * rsqrtf(sq + EPSV) * 0.125f;
    }
    if (t < cs) {
        const float a = bf2f(P[(size_t)(it.row0 + t) * PC + C_AC + h]), bb = bf2f(P[(size_t)(it.row0 + t) * PC + C_BC + h]);
        const float xs = a + p.dt_bias[l * 4 + h];
        const float sp = xs > 20.f ? xs : log1pf(expf(xs));
        Gs[t] = -expf(p.a_log[l * 4 + h]) * sp;
        Bs[t] = 1.f / (1.f + expf(-bb));
    }
    __syncthreads();
    if (w == 0) {
        float v = lane < cs ? Gs[lane] : 0.f;
#pragma unroll
        for (int o = 1; o < 64; o <<= 1) { const float n = __shfl_up(v, o); if (lane >= o) v += n; }
        if (lane < cs) Gs[lane] = v;
    }
    __syncthreads();
    const bool act = (w * 16 < cs);
    f32x4 qreg[4];
    if (act) {
        f32x4 aK[4], aQ[4];
#pragma unroll
        for (int jt = 0; jt < 4; ++jt) {
            aK[jt] = (f32x4){0.f, 0.f, 0.f, 0.f}; aQ[jt] = aK[jt];
            if (jt * 16 < cs) {
                aK[jt] = mm16(Ks + w * 16 * 65, 65, 1, Ks + jt * 16 * 65, 1, 65, 64, aK[jt], lane);
                aQ[jt] = mm16(X + w * 16 * 129 + 64, 129, 1, Ks + jt * 16 * 65, 1, 65, 64, aQ[jt], lane);
            }
        }
#pragma unroll
        for (int nt = 0; nt < 4; ++nt)
#pragma unroll
            for (int r = 0; r < 4; ++r) { const int i = w * 16 + fq * 4 + r; qreg[nt][r] = X[i * 129 + 64 + nt * 16 + fr] * expf(Gs[i]); }
#pragma unroll
        for (int jt = 0; jt < 4; ++jt)
            if (jt * 16 < cs) {
#pragma unroll
                for (int r = 0; r < 4; ++r) {
                    const int i = w * 16 + fq * 4 + r, j = jt * 16 + fr;
                    const float dec = (j <= i) ? expf(Gs[i] - Gs[j]) : 0.f;
                    Am[i * 65 + j] = (j < i) ? Bs[i] * aK[jt][r] * dec : 0.f;
                    QKm[i * 66 + j] = f2bf(aQ[jt][r] * dec);
                }
            }
    }
    __syncthreads();
    for (int e = t; e < cs * 64; e += 256) {
        const int i = e >> 6, d = e & 63;
        const float b = Bs[i];
        X[i * 129 + 64 + d] = b * expf(Gs[i]) * Ks[i * 65 + d];
        X[i * 129 + d] *= b;
    }
    __syncthreads();
    for (int r0 = 0; r0 < cs; r0 += 16) {
        if (r0 > 0) {
#pragma unroll
            for (int q2 = 0; q2 < 2; ++q2) {
                const int ct = w * 2 + q2;
                f32x4 z = (f32x4){0.f, 0.f, 0.f, 0.f};
                const f32x4 c = mm16s(Am + r0 * 65, 65, 1, X + ct * 16, 129, 1, r0, z, lane);
#pragma unroll
                for (int r = 0; r < 4; ++r) X[(r0 + fq * 4 + r) * 129 + ct * 16 + fr] -= c[r];
            }
            __syncthreads();
        }
        if (t < 128) {
            float x[16];
#pragma unroll
            for (int i = 0; i < 16; ++i) x[i] = X[(r0 + i) * 129 + t];
#pragma unroll
            for (int i = 1; i < 16; ++i) {
                const float* ar = Am + (r0 + i) * 65 + r0;
#pragma unroll
                for (int j = 0; j < i; ++j) x[i] -= ar[j] * x[j];
            }
#pragma unroll
            for (int i = 1; i < 16; ++i) X[(r0 + i) * 129 + t] = x[i];
        }
        __syncthreads();
    }
    const float gl = Gs[cs - 1];
    for (int e = t; e < cs * 64; e += 256) { const int i = e >> 6, d = e & 63; Ks[i * 65 + d] *= expf(gl - Gs[i]); }
    __syncthreads();
    float* oM = (float*)(p.ws + OFF_REG + R_DM) + (size_t)item * 4096;
    float* oN = (float*)(p.ws + OFF_REG + R_DN) + (size_t)item * 4096;
    bf16_t* oR = (bf16_t*)(p.ws + OFF_REG + R_DR) + (size_t)item * 4096;
    bf16_t* oO = (bf16_t*)(p.ws + OFF_REG + R_DO0) + (size_t)item * 4096;
    const float egl = expf(gl);
#pragma unroll
    for (int bt = 0; bt < 4; ++bt) {
        f32x4 z = (f32x4){0.f, 0.f, 0.f, 0.f};
        f32x4 cm = mm16(Ks + w * 16, 1, 65, X + 64 + bt * 16, 129, 1, cs, z, lane);
        f32x4 cn = mm16(Ks + w * 16, 1, 65, X + bt * 16, 129, 1, cs, z, lane);
#pragma unroll
        for (int r = 0; r < 4; ++r) {
            const int a = w * 16 + fq * 4 + r, b = bt * 16 + fr;
            oM[a * 64 + b] = ((a == b) ? egl : 0.f) - cm[r];
            oN[a * 64 + b] = cn[r];
        }
    }
    if (act) {
#pragma unroll
        for (int bt = 0; bt < 4; ++bt) {
            f32x4 z = (f32x4){0.f, 0.f, 0.f, 0.f};
            f32x4 cr = mm16(QKm + w * 16 * 66, 66, 1, X + 64 + bt * 16, 129, 1, cs, z, lane);
            f32x4 co = mm16(QKm + w * 16 * 66, 66, 1, X + bt * 16, 129, 1, cs, z, lane);
#pragma unroll
            for (int r = 0; r < 4; ++r) {
                const int i = w * 16 + fq * 4 + r, b = bt * 16 + fr;
                oR[i * 64 + b] = f2bf(qreg[bt][r] - cr[r]);
                oO[i * 64 + b] = f2bf(co[r]);
            }
        }
    }
}

__device__ void gla_prep(const Params& p, int l, int item, char* lds) {
    const Item it = decode_item(item);
    const int cs = it.cs, h = it.h, t = tid_opaque(), lane = t & 63, w = t >> 6, fr = lane & 15, fq = lane >> 4;
    float* Qg = (float*)lds;
    float* Kn = (float*)(lds + 8448);
    float* Kd = (float*)(lds + 16896);
    float* Gs = (float*)(lds + 25344);
    float* Vs = (float*)(lds + 33792);
    float* Att = (float*)(lds + 50432);
    const bf16_t* P = (const bf16_t*)(p.ws + OFF_REG + R_P);
    float* GL = (float*)(lds + 67072);
    float* WG = (float*)(lds + 71424);
    float* Tot = (float*)(lds + 73472);
    __syncthreads();
    for (int e = t; e < cs * 16; e += 256) GL[(e >> 4) * 17 + (e & 15)] = bf2f(P[(size_t)(it.row0 + (e >> 4)) * PC + C_GK + (e & 15)]);
    for (int e = t; e < 512; e += 256) WG[e] = p.gla_w_gk[(size_t)(l * 16 + (e >> 5)) * 128 + h * 32 + (e & 31)];
    __syncthreads();
    for (int e = t; e < cs * 32; e += 256) {
        const int tok = e >> 5, kk = e & 31;
        const bf16_t* pr = P + (size_t)(it.row0 + tok) * PC;
        Qg[tok * 33 + kk] = bf2f(pr[C_QD + h * 32 + kk]);
        Kn[tok * 33 + kk] = bf2f(pr[C_KD + h * 32 + kk]);
        float x = p.gla_b_gk[l * 128 + h * 32 + kk];
#pragma unroll
        for (int r = 0; r < 16; ++r) x += GL[tok * 17 + r] * WG[r * 32 + kk];
        const float ls = fminf(x, 0.f) - log1pf(expf(-fabsf(x)));
        Gs[tok * 33 + kk] = ls * (1.f / 16.f);
    }
    for (int e = t; e < cs * 64; e += 256) {
        const int tok = e >> 6, d = e & 63;
        Vs[tok * 65 + d] = bf2f(P[(size_t)(it.row0 + tok) * PC + C_VD + h * 64 + d]);
    }
    __syncthreads();
    {
        const int kk = t & 31, part = t >> 5, n = cs >> 3;
        float loc = 0.f;
        for (int i = 0; i < n; ++i) loc += Gs[(part * n + i) * 33 + kk];
        Tot[part * 32 + kk] = loc;
        __syncthreads();
        float base = 0.f;
        for (int pp = 0; pp < part; ++pp) base += Tot[pp * 32 + kk];
        for (int i = 0; i < n; ++i) { base += Gs[(part * n + i) * 33 + kk]; Gs[(part * n + i) * 33 + kk] = base; }
    }
    __syncthreads();
    bf16_t* oQ = (bf16_t*)(p.ws + OFF_REG + R_GQ) + (size_t)item * 2048;
    for (int e = t; e < cs * 32; e += 256) {
        const int tok = e >> 5, kk = e & 31;
        const float G = Gs[tok * 33 + kk], gl = Gs[(cs - 1) * 33 + kk], q = Qg[tok * 33 + kk], k = Kn[tok * 33 + kk];
        const float qg = q * 0.17677669529663687f * expf(G);
        Qg[tok * 33 + kk] = qg; Kn[tok * 33 + kk] = k * expf(-G); Kd[tok * 33 + kk] = k * expf(gl - G);
        oQ[tok * 32 + kk] = f2bf(qg);
    }
    if (t < 32) ((float*)(p.ws + OFF_REG + R_GD))[(size_t)item * 32 + t] = expf(Gs[(cs - 1) * 33 + t]);
    __syncthreads();
    const bool act = (w * 16 < cs);
    if (act) {
#pragma unroll
        for (int jt = 0; jt < 4; ++jt)
            if (jt * 16 < cs) {
                f32x4 z = (f32x4){0.f, 0.f, 0.f, 0.f};
                f32x4 a = mm16(Qg + w * 16 * 33, 33, 1, Kn + jt * 16 * 33, 1, 33, 32, z, lane);
#pragma unroll
                for (int r = 0; r < 4; ++r) { const int i = w * 16 + fq * 4 + r, j = jt * 16 + fr; Att[i * 65 + j] = (j <= i) ? a[r] : 0.f; }
            }
    }
    float* oN = (float*)(p.ws + OFF_REG + R_GN) + (size_t)item * 2048;
#pragma unroll
    for (int q2 = 0; q2 < 2; ++q2) {
        const int tile = w + 4 * q2, at = tile >> 2, vt = tile & 3;
        f32x4 z = (f32x4){0.f, 0.f, 0.f, 0.f};
        f32x4 cn = mm16(Kd + at * 16, 1, 33, Vs + vt * 16, 65, 1, cs, z, lane);
#pragma unroll
        for (int r = 0; r < 4; ++r) oN[(at * 16 + fq * 4 + r) * 64 + vt * 16 + fr] = cn[r];
    }
    __syncthreads();
    if (act) {
        bf16_t* oO = (bf16_t*)(p.ws + OFF_REG + R_GO0) + (size_t)item * 4096;
#pragma unroll
        for (int vt = 0; vt < 4; ++vt) {
            f32x4 z = (f32x4){0.f, 0.f, 0.f, 0.f};
            f32x4 co = mm16(Att + w * 16 * 65, 65, 1, Vs + vt * 16, 65, 1, cs, z, lane);
#pragma unroll
            for (int r = 0; r < 4; ++r) oO[(w * 16 + fq * 4 + r) * 64 + vt * 16 + fr] = f2bf(co[r]);
        }
    }
}

__device__ void delta_scan(const Params& p, int l, int idx, char* lds) {
    const int t = tid_opaque(), lane = t & 63, w = t >> 6, fr = lane & 15, fq = lane >> 4;
    float* Sl = (float*)lds;
    int item0, nsteps, v0; float* outp; const float* s0 = nullptr;
    if (idx < 128) { const int bh = idx >> 2; v0 = (idx & 3) * 16; item0 = bh * 32; nsteps = 32; outp = p.out + O_DELTAP + ((size_t)l * 32 + bh) * 4096; }
    else { const int s = idx - 128, bh = s >> 2; v0 = (s & 3) * 16; item0 = 1024 + bh; nsteps = 1; outp = p.out + O_DELTAS + ((size_t)l * 128 + bh) * 4096;
           s0 = p.state_delta + ((size_t)l * 128 + bh) * 4096; }
    const float* gM = (const float*)(p.ws + OFF_REG + R_DM);
    const float* gN = (const float*)(p.ws + OFF_REG + R_DN);
    float* gS = (float*)(p.ws + OFF_REG + R_DS);
    f32x4 sreg;
#pragma unroll
    for (int r = 0; r < 4; ++r) sreg[r] = s0 ? s0[(w * 16 + fq * 4 + r) * 64 + v0 + fr] : 0.f;
    __syncthreads();
#pragma unroll
    for (int r = 0; r < 4; ++r) Sl[(w * 16 + fq * 4 + r) * 17 + fr] = sreg[r];
    __syncthreads();
    for (int c = 0; c < nsteps; ++c) {
        const size_t ib = (size_t)(item0 + c) * 4096;
        float aM[16];
#pragma unroll
        for (int kk = 0; kk < 16; ++kk) aM[kk] = gM[ib + (w * 16 + fr) * 64 + kk * 4 + fq];
        f32x4 acc;
#pragma unroll
        for (int r = 0; r < 4; ++r) { const int a = w * 16 + fq * 4 + r; acc[r] = gN[ib + a * 64 + v0 + fr]; gS[ib + a * 64 + v0 + fr] = sreg[r]; }
#pragma unroll
        for (int kk = 0; kk < 16; ++kk) acc = __builtin_amdgcn_mfma_f32_16x16x4f32(aM[kk], Sl[(kk * 4 + fq) * 17 + fr], acc, 0, 0, 0);
        __syncthreads();
        sreg = acc;
#pragma unroll
        for (int r = 0; r < 4; ++r) Sl[(w * 16 + fq * 4 + r) * 17 + fr] = sreg[r];
        __syncthreads();
    }
#pragma unroll
    for (int r = 0; r < 4; ++r) outp[(w * 16 + fq * 4 + r) * 64 + v0 + fr] = sreg[r];
}

__device__ void gla_scan(const Params& p, int l, int idx) {
    const int t = tid_opaque();
    int item0, nsteps, e; float* outp; float S = 0.f;
    if (idx < 256) { const int bh = idx >> 3; e = (idx & 7) * 256 + t; item0 = bh * 32; nsteps = 32; outp = p.out + O_GLAP + ((size_t)l * 32 + bh) * 2048; }
    else { const int s = idx - 256, bh = s >> 3; e = (s & 7) * 256 + t; item0 = 1024 + bh; nsteps = 1; outp = p.out + O_GLAS + ((size_t)l * 128 + bh) * 2048;
           S = p.state_gla[((size_t)l * 128 + bh) * 2048 + e]; }
    const float* gN = (const float*)(p.ws + OFF_REG + R_GN);
    const float* gD = (const float*)(p.ws + OFF_REG + R_GD);
    float* gS = (float*)(p.ws + OFF_REG + R_GS);
    const int a = e >> 6;
    for (int c = 0; c < nsteps; ++c) {
        const size_t ib = (size_t)(item0 + c);
        gS[ib * 2048 + e] = S;
        S = gD[ib * 32 + a] * S + gN[ib * 2048 + e];
    }
    outp[e] = S;
}

__device__ void attn_item(const Params& p, int l, int item, char* lds) {
    bf16_t* Ks = (bf16_t*)lds;
    bf16_t* Vt = (bf16_t*)(lds + 9216);
    float* bias = (float*)(lds + 18432);
    const bf16_t* P = (const bf16_t*)(p.ws + OFF_REG + R_P);
    bf16_t* mix = (bf16_t*)(p.ws + OFF_REG + R_MIX);
    const int t = tid_opaque(), lane = t & 63, w = t >> 6, fr = lane & 15, fq = lane >> 4;
    int b, h, c = 0, nq, qrow0, nkb, kb0 = 0; bool sample;
    if (item < 1024) { b = item >> 7; c = (item >> 2) & 31; h = item & 3; nq = 64; qrow0 = b * 2048 + c * 64; kb0 = c > 8 ? c - 8 : 0; nkb = c - kb0 + 1; sample = false; }
    else { const int s = item - 1024; b = s >> 2; h = s & 3; nq = 32; qrow0 = NPROMPT + b * 32; nkb = 9; sample = true; }
    __syncthreads();
    for (int i = t; i < 513; i += 256) bias[i] = p.rel_bias[(size_t)(l * 4 + h) * 513 + i];
    const bool act = (w * 16 < nq);
    bf16x8 qf0 = {0, 0, 0, 0, 0, 0, 0, 0}, qf1 = qf0;
    if (act) { const bf16_t* qp = P + (size_t)(qrow0 + w * 16 + fr) * PC + C_QB + h * 64 + fq * 8; qf0 = *(const bf16x8*)qp; qf1 = *(const bf16x8*)(qp + 32); }
    float m = -1e30f, lsum = 0.f;
    f32x4 o[4];
#pragma unroll
    for (int i = 0; i < 4; ++i) o[i] = (f32x4){0.f, 0.f, 0.f, 0.f};
    const int qi = w * 16 + fr;
    const int key = t >> 2, dc = (t & 3) * 16;
    for (int kb = 0; kb < nkb; ++kb) {
        int nvalid = 64, relbase;
        uint4 k0, k1, v0, v1;
        if (!sample) {
            relbase = (kb0 + kb - c) * 64;
            const bf16_t* kp = P + (size_t)(b * 2048 + (kb0 + kb) * 64 + key) * PC + C_KB + h * 64 + dc;
            k0 = *(const uint4*)kp; k1 = *(const uint4*)(kp + 8); v0 = *(const uint4*)(kp + 256); v1 = *(const uint4*)(kp + 264);
        } else if (kb < 8) {
            relbase = kb * 64 - 512;
            const size_t off = ((((size_t)l * 32 + b) * 4 + h) * 512 + kb * 64 + key) * 64 + dc;
            const float4* kp = (const float4*)(p.cache_k + off); const float4* vp = (const float4*)(p.cache_v + off);
            float4 a = kp[0], bb = kp[1], cc = kp[2], dd = kp[3];
            k0.x = pack2(a.x, a.y); k0.y = pack2(a.z, a.w); k0.z = pack2(bb.x, bb.y); k0.w = pack2(bb.z, bb.w);
            k1.x = pack2(cc.x, cc.y); k1.y = pack2(cc.z, cc.w); k1.z = pack2(dd.x, dd.y); k1.w = pack2(dd.z, dd.w);
            a = vp[0]; bb = vp[1]; cc = vp[2]; dd = vp[3];
            v0.x = pack2(a.x, a.y); v0.y = pack2(a.z, a.w); v0.z = pack2(bb.x, bb.y); v0.w = pack2(bb.z, bb.w);
            v1.x = pack2(cc.x, cc.y); v1.y = pack2(cc.z, cc.w); v1.z = pack2(dd.x, dd.y); v1.w = pack2(dd.z, dd.w);
        } else {
            relbase = 0; nvalid = 32;
            k0 = make_uint4(0, 0, 0, 0); k1 = k0; v0 = k0; v1 = k0;
            if (key < 32) {
                const bf16_t* kp = P + (size_t)(NPROMPT + b * 32 + key) * PC + C_KB + h * 64 + dc;
                k0 = *(const uint4*)kp; k1 = *(const uint4*)(kp + 8); v0 = *(const uint4*)(kp + 256); v1 = *(const uint4*)(kp + 264);
            }
        }
        __syncthreads();
        *(uint4*)(Ks + key * 72 + dc) = k0; *(uint4*)(Ks + key * 72 + dc + 8) = k1;
        {
            const unsigned vv[8] = {v0.x, v0.y, v0.z, v0.w, v1.x, v1.y, v1.z, v1.w};
#pragma unroll
            for (int j = 0; j < 8; ++j) { Vt[(dc + 2 * j) * 72 + key] = (bf16_t)(vv[j] & 0xffffu); Vt[(dc + 2 * j + 1) * 72 + key] = (bf16_t)(vv[j] >> 16); }
        }
        __syncthreads();
        if (act) {
            f32x4 s[4];
#pragma unroll
            for (int tt = 0; tt < 4; ++tt) {
                const bf16_t* kr = Ks + (tt * 16 + fr) * 72 + fq * 8;
                f32x4 z = (f32x4){0.f, 0.f, 0.f, 0.f};
                z = __builtin_amdgcn_mfma_f32_16x16x32_bf16(*(const bf16x8*)kr, qf0, z, 0, 0, 0);
                z = __builtin_amdgcn_mfma_f32_16x16x32_bf16(*(const bf16x8*)(kr + 32), qf1, z, 0, 0, 0);
                s[tt] = z;
            }
            float mb = -1e30f;
#pragma unroll
            for (int tt = 0; tt < 4; ++tt)
#pragma unroll
                for (int r = 0; r < 4; ++r) {
                    const int kj = tt * 16 + fq * 4 + r;
                    int rel = relbase + kj - qi; rel = rel < -256 ? -256 : (rel > 256 ? 256 : rel);
                    float sc = s[tt][r] * 0.125f + bias[rel + 256];
                    sc = (kj < nvalid) ? sc : -1e30f;
                    s[tt][r] = sc; mb = fmaxf(mb, sc);
                }
            mb = fmaxf(mb, __shfl_xor(mb, 16)); mb = fmaxf(mb, __shfl_xor(mb, 32));
            const float mn = fmaxf(m, mb), alpha = __expf(m - mn);
            m = mn;
            float ps = 0.f;
#pragma unroll
            for (int tt = 0; tt < 4; ++tt)
#pragma unroll
                for (int r = 0; r < 4; ++r) { const float pv = __expf(s[tt][r] - mn); s[tt][r] = pv; ps += pv; }
            lsum = lsum * alpha + ps;
#pragma unroll
            for (int dt = 0; dt < 4; ++dt) o[dt] *= alpha;
#pragma unroll
            for (int u = 0; u < 2; ++u) {
                union { bf16x8 v; unsigned q[4]; } pf;
                pf.q[0] = pack2(s[2 * u][0], s[2 * u][1]); pf.q[1] = pack2(s[2 * u][2], s[2 * u][3]);
                pf.q[2] = pack2(s[2 * u + 1][0], s[2 * u + 1][1]); pf.q[3] = pack2(s[2 * u + 1][2], s[2 * u + 1][3]);
#pragma unroll
                for (int dt = 0; dt < 4; ++dt) {
                    const bf16_t* vr = Vt + (dt * 16 + fr) * 72 + u * 32 + fq * 4;
                    union { bf16x8 v; uint2 q[2]; } vf;
                    vf.q[0] = *(const uint2*)vr; vf.q[1] = *(const uint2*)(vr + 16);
                    o[dt] = __builtin_amdgcn_mfma_f32_16x16x32_bf16(vf.v, pf.v, o[dt], 0, 0, 0);
                }
            }
        }
    }
    if (act) {
        lsum += __shfl_xor(lsum, 16); lsum += __shfl_xor(lsum, 32);
        const float inv = 1.f / lsum;
        bf16_t* op = mix + (size_t)(qrow0 + qi) * DM + 256 + h * 64 + fq * 4;
#pragma unroll
        for (int dt = 0; dt < 4; ++dt) { uint2 ov; ov.x = pack2(o[dt][0] * inv, o[dt][1] * inv); ov.y = pack2(o[dt][2] * inv, o[dt][3] * inv); *(uint2*)(op + dt * 16) = ov; }
    }
}

__device__ void delta_out(const Params& p, int l, int item, char* lds) {
    const Item it = decode_item(item);
    const int cs = it.cs, h = it.h, t = tid_opaque(), lane = t & 63, w = t >> 6, fr = lane & 15, fq = lane >> 4;
    bf16_t* Rl = (bf16_t*)lds;
    float* Sl = (float*)(lds + 8448);
    const bf16_t* gR = (const bf16_t*)(p.ws + OFF_REG + R_DR) + (size_t)item * 4096;
    const bf16_t* gO = (const bf16_t*)(p.ws + OFF_REG + R_DO0) + (size_t)item * 4096;
    const float* gS = (const float*)(p.ws + OFF_REG + R_DS) + (size_t)item * 4096;
    const bf16_t* P = (const bf16_t*)(p.ws + OFF_REG + R_P);
    bf16_t* mix = (bf16_t*)(p.ws + OFF_REG + R_MIX);
    __syncthreads();
    for (int e = t; e < cs * 64; e += 256) Rl[(e >> 6) * 66 + (e & 63)] = gR[e];
    for (int e = t; e < 4096; e += 256) Sl[(e >> 6) * 65 + (e & 63)] = gS[e];
    __syncthreads();
    if (w * 16 < cs) {
        f32x4 acc[4]; float ss[4] = {0.f, 0.f, 0.f, 0.f};
#pragma unroll
        for (int vt = 0; vt < 4; ++vt) {
#pragma unroll
            for (int r = 0; r < 4; ++r) acc[vt][r] = bf2f(gO[(w * 16 + fq * 4 + r) * 64 + vt * 16 + fr]);
            acc[vt] = mm16(Rl + w * 16 * 66, 66, 1, Sl + vt * 16, 65, 1, 64, acc[vt], lane);
#pragma unroll
            for (int r = 0; r < 4; ++r) ss[r] += acc[vt][r] * acc[vt][r];
        }
#pragma unroll
        for (int r = 0; r < 4; ++r) {
            float s = ss[r];
            s += __shfl_xor(s, 1); s += __shfl_xor(s, 2); s += __shfl_xor(s, 4); s += __shfl_xor(s, 8);
            const float rs = rsqrtf(s * (1.f / 64.f) + EPSV);
            const int row = it.row0 + w * 16 + fq * 4 + r;
#pragma unroll
            for (int vt = 0; vt < 4; ++vt) {
                const int v = vt * 16 + fr;
                const float z = bf2f(P[(size_t)row * PC + C_ZC + h * 64 + v]);
                mix[(size_t)row * DM + 512 + h * 64 + v] = f2bf(acc[vt][r] * rs * p.delta_norm_g[l * 64 + v] * siluf(z));
            }
        }
    }
}
__device__ void gla_out(const Params& p, int l, int item, char* lds) {
    const Item it = decode_item(item);
    const int cs = it.cs, h = it.h, t = tid_opaque(), lane = t & 63, w = t >> 6, fr = lane & 15, fq = lane >> 4;
    bf16_t* Ql = (bf16_t*)lds;
    float* Sl = (float*)(lds + 4352);
    const bf16_t* gQ = (const bf16_t*)(p.ws + OFF_REG + R_GQ) + (size_t)item * 2048;
    const bf16_t* gO = (const bf16_t*)(p.ws + OFF_REG + R_GO0) + (size_t)item * 4096;
    const float* gS = (const float*)(p.ws + OFF_REG + R_GS) + (size_t)item * 2048;
    const bf16_t* P = (const bf16_t*)(p.ws + OFF_REG + R_P);
    bf16_t* mix = (bf16_t*)(p.ws + OFF_REG + R_MIX);
    __syncthreads();
    for (int e = t; e < cs * 32; e += 256) Ql[(e >> 5) * 34 + (e & 31)] = gQ[e];
    for (int e = t; e < 2048; e += 256) Sl[(e >> 6) * 65 + (e & 63)] = gS[e];
    __syncthreads();
    if (w * 16 < cs) {
        f32x4 acc[4]; float ss[4] = {0.f, 0.f, 0.f, 0.f};
#pragma unroll
        for (int vt = 0; vt < 4; ++vt) {
#pragma unroll
            for (int r = 0; r < 4; ++r) acc[vt][r] = bf2f(gO[(w * 16 + fq * 4 + r) * 64 + vt * 16 + fr]);
            acc[vt] = mm16(Ql + w * 16 * 34, 34, 1, Sl + vt * 16, 65, 1, 32, acc[vt], lane);
#pragma unroll
            for (int r = 0; r < 4; ++r) ss[r] += acc[vt][r] * acc[vt][r];
        }
#pragma unroll
        for (int r = 0; r < 4; ++r) {
            float s = ss[r];
            s += __shfl_xor(s, 1); s += __shfl_xor(s, 2); s += __shfl_xor(s, 4); s += __shfl_xor(s, 8);
            const float rs = rsqrtf(s * (1.f / 64.f) + EPSV);
            const int row = it.row0 + w * 16 + fq * 4 + r;
#pragma unroll
            for (int vt = 0; vt < 4; ++vt) {
                const int v = vt * 16 + fr;
                const float z = bf2f(P[(size_t)row * PC + C_GD + h * 64 + v]);
                mix[(size_t)row * DM + 768 + h * 64 + v] = f2bf(acc[vt][r] * rs * p.gla_norm_g[l * 64 + v] * siluf(z));
            }
        }
    }
}

__device__ void pool_item(const Params& p, int l, int item, char* lds) {
    const int tile = item >> 2, g = item & 3, win = 2 << g;
    const int t = tid_opaque(), lane = t & 63, w = t >> 6, fr = lane & 15, fq = lane >> 4;
    float* Wl = (float*)lds;
    float* U = (float*)(lds + 16640);
    float* Pl = (float*)(lds + 28672);
    const bf16_t* P = (const bf16_t*)(p.ws + OFF_REG + R_P);
    bf16_t* mix = (bf16_t*)(p.ws + OFF_REG + R_MIX);
    int b, t0, row0; bool sample;
    if (tile < 512) { b = tile >> 6; t0 = (tile & 63) * 32; row0 = b * 2048 + t0; sample = false; }
    else { b = tile - 512; t0 = 0; row0 = NPROMPT + b * 32; sample = true; }
    __syncthreads();
    for (int e = t; e < 4096; e += 256) Wl[(e >> 6) * 65 + (e & 63)] = p.pool_w[((size_t)(l * 4 + g) * 64) * 64 + e];
    for (int e = t; e < 47 * 64; e += 256) {
        const int r = e >> 6, ch = e & 63, tt = r - 15;
        float v;
        if (t0 + tt >= 0) v = bf2f(P[(size_t)(row0 + tt) * PC + C_UA + g * 64 + ch]);
        else v = sample ? p.cache_pool[((size_t)(l * 32 + b) * 15 + (15 + tt)) * 256 + g * 64 + ch] : 0.f;
        U[e] = v;
    }
    __syncthreads();
    for (int e = t; e < 32 * 64; e += 256) {
        const int tt = e >> 6, ch = e & 63;
        float s = 0.f;
        for (int j = 0; j < win; ++j) s += U[(15 + tt - j) * 64 + ch];
        const int pos1 = t0 + tt + 1;
        const float cnt = (sample || pos1 > win) ? (float)win : (float)pos1;
        Pl[tt * 65 + ch] = s / cnt - U[(15 + tt) * 64 + ch];
    }
    __syncthreads();
#pragma unroll
    for (int mt = 0; mt < 2; ++mt) {
        f32x4 z = (f32x4){0.f, 0.f, 0.f, 0.f};
        f32x4 y = mm16(Pl + mt * 16 * 65, 65, 1, Wl + w * 16, 65, 1, 64, z, lane);
        const int d = g * 64 + w * 16 + fr;
        const float sc = p.pool_scale[l * 256 + d];
#pragma unroll
        for (int r = 0; r < 4; ++r) mix[(size_t)(row0 + mt * 16 + fq * 4 + r) * DM + d] = f2bf(y[r] * sc);
    }
}

__device__ void copy_outs(const Params& p, int l) {
    const bf16_t* P = (const bf16_t*)(p.ws + OFF_REG + R_P);
    int t512 = threadIdx.x; asm volatile("" : "+v"(t512));
    const size_t gt = (size_t)blockIdx.x * 512 + t512, gs = (size_t)gridDim.x * 512;
    for (size_t e = gt; e < 2 * 1048576; e += gs) {
        const int kv = (int)(e >> 20), r = (int)(e & 1048575), d = r & 63, j = (r >> 6) & 511, h = (r >> 15) & 3, b = r >> 17;
        p.out[(kv ? O_VP : O_KP) + (size_t)l * 1048576 + r] = bf2f(P[(size_t)(b * 2048 + 1536 + j) * PC + (kv ? C_VB : C_KB) + h * 64 + d]);
    }
    for (size_t e = gt; e < 2 * 262144; e += gs) {
        const int kv = (int)(e >> 18), r = (int)(e & 262143), d = r & 63, j = (r >> 6) & 31, h = (r >> 11) & 3, b = r >> 13;
        p.out[(kv ? O_VS : O_KS) + (size_t)l * 262144 + r] = bf2f(P[(size_t)(NPROMPT + b * 32 + j) * PC + (kv ? C_VB : C_KB) + h * 64 + d]);
    }
    for (size_t e = gt; e < 40 * 3840; e += gs) {
        const int bb = (int)(e / 3840), r = (int)(e % 3840), rr = r >> 8, ch = r & 255;
        if (bb < 8) p.out[O_POOLP + (size_t)l * 30720 + e] = bf2f(P[(size_t)(bb * 2048 + 2033 + rr) * PC + C_UA + ch]);
        else p.out[O_POOLS + (size_t)l * 122880 + (e - 30720)] = bf2f(P[(size_t)(NPROMPT + (bb - 8) * 32 + 17 + rr) * PC + C_UA + ch]);
    }
    for (size_t e = gt; e < 40 * 2304; e += gs) {
        const int bb = (int)(e / 2304), r = (int)(e % 2304), rr = r / 768, ch = r % 768;
        if (bb < 8) p.out[O_CONVP + (size_t)l * 18432 + e] = bf2f(P[(size_t)(bb * 2048 + 2045 + rr) * PC + C_QC + ch]);
        else p.out[O_CONVS + (size_t)l * 73728 + (e - 18432)] = bf2f(P[(size_t)(NPROMPT + (bb - 8) * 32 + 29 + rr) * PC + C_QC + ch]);
    }
}

__device__ void final_rows(const Params& p, int it) {
    const int w = tid_opaque() >> 6, lane = tid_opaque() & 63, row = it * 4 + w;
    const float* xres = (const float*)(p.ws + OFF_XRES) + (size_t)row * DM;
    const f32x4* pp = (const f32x4*)((const float*)(p.ws + OFF_SSQ) + (size_t)row * 16);
    const f32x4 pa = (pp[0] + pp[1]) + (pp[2] + pp[3]);
    const float rs = rsqrtf(((pa[0] + pa[1]) + (pa[2] + pa[3])) * (1.f / DM) + EPSV);
    float* y = p.out + (size_t)row * DM;
#pragma unroll
    for (int i = 0; i < 4; ++i) {
        const int c = lane * 4 + 256 * i;
        float4 v = *(const float4*)(xres + c); const float4 g = *(const float4*)(p.final_norm_g + c);
        v.x *= rs * g.x; v.y *= rs * g.y; v.z *= rs * g.z; v.w *= rs * g.w;
        *(float4*)(y + c) = v;
    }
}

#define ITEMS(total) for (int k_ = B; 2 * k_ < (total); k_ += G)
__device__ void run_phase(const Params& pin, int ph, char* lds0) {
    Params p = pin;
#define LAUNDER(f) asm volatile("" : "+s"(p.f))
    LAUNDER(x_prompt); LAUNDER(x_sample); LAUNDER(cache_pool); LAUNDER(cache_k); LAUNDER(cache_v); LAUNDER(state_conv); LAUNDER(state_delta); LAUNDER(state_gla);
    LAUNDER(attn_norm_g); LAUNDER(w_in); LAUNDER(pool_w); LAUNDER(pool_scale); LAUNDER(rel_bias); LAUNDER(conv_w); LAUNDER(a_log); LAUNDER(dt_bias); LAUNDER(delta_norm_g);
    LAUNDER(gla_w_gk); LAUNDER(gla_b_gk); LAUNDER(gla_norm_g); LAUNDER(w_out); LAUNDER(mlp_norm_g); LAUNDER(w_up); LAUNDER(w_down); LAUNDER(final_norm_g);
    LAUNDER(out); LAUNDER(ws);
#undef LAUNDER
    int thr_ = threadIdx.x; asm volatile("" : "+v"(thr_));
    const int G = gridDim.x, B = blockIdx.x, half = thr_ >> 8;
    char* lds = lds0 + half * HALF_LDS;
    if (ph == 0) {
        ITEMS(CV_TOTAL + NTOK / 4) { const int it = 2 * k_ + half;
            if (it < CV_TOTAL) convert_layer_item(p, 0, it, lds); else prologue_rows(p, it - CV_TOTAL);
        }
        return;
    }
    if (ph == 1 + 7 * DEPTH) { ITEMS(NTOK / 4) { final_rows(p, 2 * k_ + half); } return; }
    const int l = (ph - 1) / 7, sp = (ph - 1) % 7;
    const bf16_t* wb = (const bf16_t*)(p.ws + ((l & 1) ? OFF_WB1 : OFF_WB0));
    float* ssq = (float*)(p.ws + OFF_SSQ);
    bf16_t* xb = (bf16_t*)(p.ws + OFF_XB);
    float* xres = (float*)(p.ws + OFF_XRES);
    if (sp == 0) {
        EpiNorm<0> e; e.O = (bf16_t*)(p.ws + OFF_REG + R_P); e.ldc = PC; e.ssq = ssq;
        gemm_run(lds0, xb, wb + WB_IN, PC, DM, e);
    } else if (sp == 1) {
        ITEMS(2 * NITEM) { const int it = 2 * k_ + half; if (it < NITEM) delta_prep(p, l, it, lds); else gla_prep(p, l, it - NITEM, lds); }
    } else if (sp == 2) {
        ITEMS(128 + 256 + NITEM + 512 + 1024) {
            int i = 2 * k_ + half;
            if (i < 128) delta_scan(p, l, i, lds);
            else if ((i -= 128) < 256) gla_scan(p, l, i);
            else if ((i -= 256) < NITEM) attn_item(p, l, i, lds);
            else if ((i -= NITEM) < 512) delta_scan(p, l, 128 + i, lds);
            else gla_scan(p, l, 256 + (i - 512));
        }
    } else if (sp == 3) {
        const int ncv = (l + 1 < DEPTH) ? CV_TOTAL : 0;
        ITEMS(2 * NITEM + 2176 + ncv) {
            int i = 2 * k_ + half;
            if (i < NITEM) delta_out(p, l, i, lds);
            else if ((i -= NITEM) < NITEM) gla_out(p, l, i, lds);
            else if ((i -= NITEM) < 2176) pool_item(p, l, i, lds);
            else convert_layer_item(p, l + 1, i - 2176, lds);
        }
        copy_outs(p, l);
    } else if (sp == 4) {
        EpiRes e; e.xres = xres; e.xb = xb; e.ssq = ssq;
        gemm_run(lds0, (const bf16_t*)(p.ws + OFF_REG + R_MIX), wb + WB_OUT, DM, DM, e);
    } else if (sp == 5) {
        EpiNorm<1> e; e.O = (bf16_t*)(p.ws + OFF_REG); e.ldc = DFF; e.ssq = ssq;
        gemm_run(lds0, xb, wb + WB_UP, DFF, DM, e);
    } else {
        EpiRes e; e.xres = xres; e.xb = xb; e.ssq = ssq;
        gemm_run(lds0, (const bf16_t*)(p.ws + OFF_REG), wb + WB_DN, DM, DFF, e);
    }
}
#define XB_TMO      128
#define XB_XCNT(j)  (256  + 64 * (j))
#define XB_XSUB(j)  (1280 + 64 * (j))
#define XB_XGEN(j)  (2304 + 64 * (j))
#define XB_TOP      3328
#define XB_TOPGEN   3392
#define XCD_BAR_WORDS 3456
#define XB_SPIN_CAP (1u << 22)
#define LAS __attribute__((address_space(3)))
__device__ __forceinline__ unsigned xb_ld(unsigned* p)              { return __hip_atomic_load(p, __ATOMIC_RELAXED, __HIP_MEMORY_SCOPE_AGENT); }
__device__ __forceinline__ unsigned xb_add(unsigned* p, unsigned v) { return __hip_atomic_fetch_add(p, v, __ATOMIC_RELAXED, __HIP_MEMORY_SCOPE_AGENT); }
__device__ __forceinline__ unsigned xb_xcc_id() { return (unsigned)__builtin_amdgcn_s_getreg((3 << 11) | 20) & 0xFu; }
#define XB_SPIN(cond, bar) do { unsigned _sp = 0; while (cond) { __builtin_amdgcn_s_sleep(1); \
    if ((++_sp & 255u) == 0u) { if (xb_ld(&(bar)[XB_TMO])) break; if (_sp > XB_SPIN_CAP) { atomicAdd(&(bar)[XB_TMO], 1u); break; } } } } while (0)
struct XcdBarrier { unsigned* bar; unsigned x; volatile LAS unsigned* st; };
__device__ __forceinline__ XcdBarrier xcd_barrier_post(unsigned* bar, volatile LAS unsigned* st) {
    XcdBarrier b; b.bar = bar; b.x = xb_xcc_id(); b.st = st;
    if (threadIdx.x == 0) (void)xb_add(&bar[XB_XCNT(b.x)], 1u);
    return b;
}
__device__ __forceinline__ void xcd_barrier_complete(unsigned* bar, unsigned x, unsigned& nloc, unsigned& nx) {
    const unsigned G = gridDim.x * gridDim.y * gridDim.z;
    unsigned sum, cnt, mine, sp = 0u;
    for (;;) {
        sum = 0u; cnt = 0u; mine = 0u;
#pragma unroll
        for (unsigned j = 0; j < 16; ++j) { const unsigned c = xb_ld(&bar[XB_XCNT(j)]); sum += c; cnt += (c > 0u) ? 1u : 0u; mine = (j == x) ? c : mine; }
        if (sum == G) break;
        __builtin_amdgcn_s_sleep(1);
        if ((++sp & 255u) == 0u) { if (xb_ld(&bar[XB_TMO])) break; if (sp > XB_SPIN_CAP) { atomicAdd(&bar[XB_TMO], 1u); break; } }
    }
    nloc = mine > 0u ? mine : 1u; nx = cnt > 0u ? cnt : 1u;
}
__device__ __forceinline__ void xcd_barrier(const XcdBarrier& b) {
    asm volatile("s_waitcnt vmcnt(0)" ::: "memory");
    __syncthreads();
    if (threadIdx.x == 0) {
        unsigned* bar = b.bar;
        __builtin_amdgcn_s_waitcnt(0);
        unsigned nloc = b.st[0], nx = b.st[1];
        if (nloc == 0u) { xcd_barrier_complete(bar, b.x, nloc, nx); b.st[0] = nloc; b.st[1] = nx; }
        const unsigned old = xb_add(&bar[XB_XSUB(b.x)], 1u);
        const unsigned gen = old / nloc;
        if (old + 1u == (gen + 1u) * nloc) {
            __builtin_amdgcn_fence(__ATOMIC_RELEASE, "agent");
            asm volatile("s_waitcnt vmcnt(0)" ::: "memory");
            const unsigned og = xb_add(&bar[XB_TOP], 1u);
            const unsigned tg = og / nx;
            if (og + 1u == (tg + 1u) * nx) xb_add(&bar[XB_TOPGEN], 1u);
            else XB_SPIN(xb_ld(&bar[XB_TOPGEN]) == tg, bar);
            __builtin_amdgcn_fence(__ATOMIC_ACQUIRE, "agent");
            xb_add(&bar[XB_XGEN(b.x)], 1u);
            asm volatile("s_waitcnt vmcnt(0)" ::: "memory");
        } else {
            XB_SPIN(xb_ld(&bar[XB_XGEN(b.x)]) == gen, bar);
            __builtin_amdgcn_fence(__ATOMIC_ACQUIRE, "agent");
            asm volatile("s_waitcnt vmcnt(0)" ::: "memory");
        }
    }
    __syncthreads();
}

constexpr int NPHASE = 2 + 7 * DEPTH;
constexpr unsigned PROBE_REP = 0x1111111u;

__global__ void __launch_bounds__(512, 2) mega(Params p) {
    extern __shared__ __attribute__((aligned(16))) char lds[];
    volatile LAS unsigned* st = (volatile LAS unsigned*)(lds + LDS_BYTES - 16);
    if (threadIdx.x == 0) { st[0] = 0u; st[1] = 0u; }
    __syncthreads();
    XcdBarrier xb = xcd_barrier_post(p.bar, st);
    for (int ph = p.ph_begin; ph < p.ph_end; ++ph) {
        const int sp_ = (ph >= 1 && ph <= 7 * DEPTH) ? (ph - 1) % 7 : -1;
        const int reps = sp_ < 0 ? 1 : ((PROBE_REP >> (4 * sp_)) & 15);
        for (int r = 0; r < reps; ++r) { run_phase(p, ph, lds); if (r + 1 < reps) xcd_barrier(xb); }
        if (ph + 1 < p.ph_end) { if (p.use_cg) cg::this_grid().sync(); else xcd_barrier(xb); }
    }
}

extern "C" void kernel_launch(void* const* d_in, const int* in_sizes, int n_in, void* d_out, int out_size, void* d_ws, size_t ws_size, hipStream_t stream) {
    static int grid_blocks = 0;
    if (!grid_blocks) {
        int dev = 0, cus = 0, per_cu = 0;
        hipGetDevice(&dev);
        hipDeviceGetAttribute(&cus, hipDeviceAttributeMultiprocessorCount, dev);
        hipFuncSetAttribute((const void*)mega, hipFuncAttributeMaxDynamicSharedMemorySize, LDS_BYTES);
        hipOccupancyMaxActiveBlocksPerMultiprocessor(&per_cu, mega, 512, LDS_BYTES);
        if (per_cu < 1) per_cu = 1;
        grid_blocks = cus * per_cu;
    }
    if (ws_size < WS_NEED) { fprintf(stderr, "workspace too small: %zu < %zu\n", ws_size, (size_t)WS_NEED); return; }
    Params p{};
    const float** f = (const float**)&p;
    for (int i = 0; i < 25; ++i) f[i] = (const float*)d_in[i];
    p.out = (float*)d_out; p.ws = (char*)d_ws; p.bar = (unsigned*)((char*)d_ws + OFF_BAR); p.use_cg = 0; p.pad0 = 0;
    hipMemsetAsync(p.bar, 0, XCD_BAR_WORDS * 4, stream);
#if ONE_LAUNCH
    p.ph_begin = 0; p.ph_end = NPHASE;
    void* args[] = {&p};
    hipError_t e = hipLaunchCooperativeKernel((void*)mega, dim3(grid_blocks), dim3(512), args, LDS_BYTES, stream);
    if (e != hipSuccess) fprintf(stderr, "cooperative launch failed: %s (grid %d)\n", hipGetErrorString(e), grid_blocks);
#else
    for (int ph = 0; ph < NPHASE; ++ph) {
        p.ph_begin = ph; p.ph_end = ph + 1;
        hipLaunchKernelGGL(mega, dim3(grid_blocks), dim3(512), LDS_BYTES, stream, p);
    }
#endif
}
```

```cpp
#include <hip/hip_runtime.h>
#include <hip/hip_cooperative_groups.h>
#include <cstdio>
#include <cstdint>
namespace cg = cooperative_groups;

#ifndef ONE_LAUNCH
#define ONE_LAUNCH 1
#endif

typedef unsigned short bf16_t;
typedef short bf16x8 __attribute__((ext_vector_type(8)));
typedef float f32x4 __attribute__((ext_vector_type(4)));
typedef unsigned u32x4 __attribute__((ext_vector_type(4)));

constexpr int DM = 1024, NTOK = 17408, NPROMPT = 16384, PC = 3072, INC = 2840, DFF = 4096, DEPTH = 4;
constexpr int C_UA = 0, C_QB = 256, C_KB = 512, C_VB = 768, C_QC = 1024, C_ZC = 1792, C_AC = 2048, C_BC = 2052,
              C_QD = 2056, C_KD = 2184, C_VD = 2312, C_GD = 2568, C_GK = 2824;
constexpr int NITEM = 1152;
constexpr float EPSV = 1e-6f;
constexpr int HALF_LDS = 77824, LDS_BYTES = 2 * HALF_LDS;

constexpr size_t WB_IN = 0, WB_OUT = (size_t)PC * DM, WB_UP = WB_OUT + (size_t)DM * DM, WB_DN = WB_UP + (size_t)DFF * DM,
                 WB_ELEMS = WB_DN + (size_t)DM * DFF;
constexpr size_t OFF_WB0 = 0, OFF_WB1 = WB_ELEMS * 2, OFF_XRES = OFF_WB1 + WB_ELEMS * 2, OFF_XB = OFF_XRES + (size_t)NTOK * DM * 4,
                 OFF_SSQ = OFF_XB + (size_t)NTOK * DM * 2, OFF_REG = OFF_SSQ + (size_t)16 * NTOK * 4;
constexpr size_t R_P = 0, R_MIX = R_P + (size_t)NTOK * PC * 2, R_DM = R_MIX + (size_t)NTOK * DM * 2, R_DN = R_DM + (size_t)NITEM * 16384,
                 R_DR = R_DN + (size_t)NITEM * 16384, R_DO0 = R_DR + (size_t)NITEM * 8192, R_DS = R_DO0 + (size_t)NITEM * 8192,
                 R_GN = R_DS + (size_t)NITEM * 16384, R_GQ = R_GN + (size_t)NITEM * 8192, R_GO0 = R_GQ + (size_t)NITEM * 4096,
                 R_GD = R_GO0 + (size_t)NITEM * 8192, R_GS = R_GD + (size_t)NITEM * 128, R_END = R_GS + (size_t)NITEM * 8192;
constexpr size_t OFF_BAR = OFF_REG + R_END;
constexpr size_t WS_NEED = OFF_BAR + 16384;
static_assert(WS_NEED <= 419197120, "workspace");
static_assert((size_t)NTOK * DFF * 2 <= R_END, "up overlay");
constexpr size_t O_YP = 0, O_YS = 16777216, O_POOLP = O_YS + 1048576, O_KP = O_POOLP + 122880, O_VP = O_KP + 4194304, O_CONVP = O_VP + 4194304,
                 O_DELTAP = O_CONVP + 73728, O_GLAP = O_DELTAP + 524288, O_POOLS = O_GLAP + 262144, O_KS = O_POOLS + 491520, O_VS = O_KS + 1048576,
                 O_CONVS = O_VS + 1048576, O_DELTAS = O_CONVS + 294912, O_GLAS = O_DELTAS + 2097152;

struct Params {
    const float *x_prompt, *x_sample, *cache_pool, *cache_k, *cache_v, *state_conv, *state_delta, *state_gla;
    const float *attn_norm_g, *w_in, *pool_w, *pool_scale, *rel_bias, *conv_w, *a_log, *dt_bias, *delta_norm_g, *gla_w_gk, *gla_b_gk,
        *gla_norm_g, *w_out, *mlp_norm_g, *w_up, *w_down, *final_norm_g;
    float* out;
    char* ws;
    unsigned* bar;
    int ph_begin, ph_end, use_cg, pad0;
};

__device__ __forceinline__ float bf2f(bf16_t v) { return __uint_as_float(((unsigned)v) << 16); }
__device__ __forceinline__ bf16_t f2bf(float f) { unsigned u = __float_as_uint(f); u += 0x7fffu + ((u >> 16) & 1u); return (bf16_t)(u >> 16); }
__device__ __forceinline__ unsigned pack2(float lo, float hi) { return (unsigned)f2bf(lo) | ((unsigned)f2bf(hi) << 16); }
__device__ __forceinline__ float ldf(const float* p) { return *p; }
__device__ __forceinline__ float ldf(const bf16_t* p) { return bf2f(*p); }
__device__ __forceinline__ float wave_sum(float v) {
#pragma unroll
    for (int o = 32; o; o >>= 1) v += __shfl_xor(v, o);
    return v;
}
__device__ __forceinline__ float siluf(float x) { return x / (1.f + expf(-x)); }

template <typename TA, typename TB>
__device__ __forceinline__ f32x4 mm16(const TA* A, int a_rs, int a_cs, const TB* B, int b_rs, int b_cs, int K, f32x4 acc, int lane) {
    const int i = lane & 15, kq = lane >> 4;
    const TA* ap = A + i * a_rs + kq * a_cs;
    const TB* bp = B + kq * b_rs + i * b_cs;
    for (int k0 = 0; k0 < K; k0 += 32) {
        float a[8], b[8];
#pragma unroll
        for (int u = 0; u < 8; ++u) { a[u] = ldf(ap + (k0 + 4 * u) * a_cs); b[u] = ldf(bp + (k0 + 4 * u) * b_rs); }
#pragma unroll
        for (int u = 0; u < 8; ++u) acc = __builtin_amdgcn_mfma_f32_16x16x4f32(a[u], b[u], acc, 0, 0, 0);
    }
    return acc;
}
template <typename TA, typename TB>
__device__ __forceinline__ f32x4 mm16s(const TA* A, int a_rs, int a_cs, const TB* B, int b_rs, int b_cs, int K, f32x4 acc, int lane) {
    const int i = lane & 15, kq = lane >> 4;
    const TA* ap = A + i * a_rs + kq * a_cs;
    const TB* bp = B + kq * b_rs + i * b_cs;
    for (int k0 = 0; k0 < K; k0 += 16) {
        float a[4], b[4];
#pragma unroll
        for (int u = 0; u < 4; ++u) { a[u] = ldf(ap + (k0 + 4 * u) * a_cs); b[u] = ldf(bp + (k0 + 4 * u) * b_rs); }
#pragma unroll
        for (int u = 0; u < 4; ++u) acc = __builtin_amdgcn_mfma_f32_16x16x4f32(a[u], b[u], acc, 0, 0, 0);
    }
    return acc;
}

__device__ __forceinline__ int tid_opaque() { int t = threadIdx.x & 255; asm volatile("" : "+v"(t)); return t; }
__device__ __forceinline__ const float* xin_row(const Params& p, int row) {
    return row < NPROMPT ? p.x_prompt + (size_t)row * DM : p.x_sample + (size_t)(row - NPROMPT) * DM;
}

__device__ void convert_tile(const float* __restrict__ src, bf16_t* __restrict__ dst, int K, int N, const float* __restrict__ g, int item, char* lds) {
    float* T = (float*)lds;
    const int nk4 = K >> 8, k4 = item % nk4, nt = item / nk4, t = tid_opaque();
    const int nl = (t & 15) * 4, n0 = nt * 64 + nl;
    float4 v[16];
#pragma unroll
    for (int q = 0; q < 4; ++q)
#pragma unroll
        for (int i = 0; i < 4; ++i) {
            const int k = k4 * 256 + q * 64 + (t >> 4) + 16 * i;
            float4 x = make_float4(0.f, 0.f, 0.f, 0.f);
            if (n0 < N) x = *(const float4*)(src + (size_t)k * N + n0);
            if (g) { const float sc = g[k]; x.x *= sc; x.y *= sc; x.z *= sc; x.w *= sc; }
            v[q * 4 + i] = x;
        }
    __syncthreads();
#pragma unroll
    for (int q = 0; q < 4; ++q)
#pragma unroll
        for (int i = 0; i < 4; ++i) {
            float* Tq = T + q * (64 * 65); const int kl = (t >> 4) + 16 * i; const float4 x = v[q * 4 + i];
            Tq[(nl + 0) * 65 + kl] = x.x; Tq[(nl + 1) * 65 + kl] = x.y; Tq[(nl + 2) * 65 + kl] = x.z; Tq[(nl + 3) * 65 + kl] = x.w;
        }
    __syncthreads();
    const int n = t >> 2, kc = (t & 3) * 16;
#pragma unroll
    for (int q = 0; q < 4; ++q) {
        const float* r = T + q * (64 * 65) + n * 65 + kc;
        u32x4 a, b;
        a[0] = pack2(r[0], r[1]); a[1] = pack2(r[2], r[3]); a[2] = pack2(r[4], r[5]); a[3] = pack2(r[6], r[7]);
        b[0] = pack2(r[8], r[9]); b[1] = pack2(r[10], r[11]); b[2] = pack2(r[12], r[13]); b[3] = pack2(r[14], r[15]);
        bf16_t* d = dst + (size_t)(nt * 64 + n) * K + k4 * 256 + q * 64 + kc;
        *(u32x4*)d = a; *(u32x4*)(d + 8) = b;
    }
}
constexpr int CV_IN = 4 * 48, CV_OUT = 4 * 16, CV_UP = 4 * 64, CV_DN = 16 * 16, CV_TOTAL = CV_IN + CV_OUT + CV_UP + CV_DN;
__device__ void convert_layer_item(const Params& p, int l, int it, char* lds) {
    bf16_t* wb = (bf16_t*)(p.ws + ((l & 1) ? OFF_WB1 : OFF_WB0));
    if (it < CV_IN) convert_tile(p.w_in + (size_t)l * DM * INC, wb + WB_IN, DM, INC, p.attn_norm_g + l * DM, it, lds);
    else if ((it -= CV_IN) < CV_OUT) convert_tile(p.w_out + (size_t)l * DM * DM, wb + WB_OUT, DM, DM, nullptr, it, lds);
    else if ((it -= CV_OUT) < CV_UP) convert_tile(p.w_up + (size_t)l * DM * DFF, wb + WB_UP, DM, DFF, p.mlp_norm_g + l * DM, it, lds);
    else { it -= CV_UP; convert_tile(p.w_down + (size_t)l * DFF * DM, wb + WB_DN, DFF, DM, nullptr, it, lds); }
}

__device__ void prologue_rows(const Params& p, int it) {
    const int w = tid_opaque() >> 6, lane = tid_opaque() & 63, row = it * 4 + w;
    const float* x = xin_row(p, row);
    float* xres = (float*)(p.ws + OFF_XRES) + (size_t)row * DM;
    bf16_t* xb = (bf16_t*)(p.ws + OFF_XB) + (size_t)row * DM;
    float* ssq = (float*)(p.ws + OFF_SSQ);
    float s = 0.f;
#pragma unroll
    for (int i = 0; i < 4; ++i) {
        const int c = lane * 4 + 256 * i;
        float4 v = *(const float4*)(x + c);
        s += v.x * v.x + v.y * v.y + v.z * v.z + v.w * v.w;
        *(float4*)(xres + c) = v;
        uint2 o; o.x = pack2(v.x, v.y); o.y = pack2(v.z, v.w);
        *(uint2*)(xb + c) = o;
    }
    s = wave_sum(s);
    if (lane < 16) ssq[(size_t)row * 16 + lane] = lane == 0 ? s : 0.f;
}

namespace pg8 {
#define PG8_LAS __attribute__((address_space(3)))
typedef unsigned short bf16_t;
typedef short bf16x8 __attribute__((ext_vector_type(8)));
typedef float f32x4 __attribute__((ext_vector_type(4)));
typedef unsigned u32x4 __attribute__((ext_vector_type(4)));
constexpr int BM = 256, BK = 64, HALF = 128, HTB = HALF * BK * 2  , STAGE_BYTES = 8 * HTB, NXCD = 8, WGM = 8;

__host__ __device__ __forceinline__ int lds_byte(int r, int c) { const int st = (r >> 4) * 2 + (c >> 5), rr = r & 15, cc = c & 31, ob = rr * 64 + cc * 2; return st * 1024 + (ob ^ (((ob >> 9) & 1) << 5)); }
__host__ __device__ __forceinline__ void stage_rc(int b, int& R, int& C) { const int st = b / 1024, sb = b % 1024, swz = sb ^ (((sb >> 9) & 1) << 5); R = (st >> 1) * 16 + swz / 64; C = (st & 1) * 32 + (swz % 64) / 2; }
__host__ __device__ __forceinline__ int perm32(int rho) { const int n = rho >> 4, i = rho & 15; return 8 * (i >> 2) + 4 * n + (i & 3); }

struct Unit { int pm, pn; };
struct Gemm { const bf16_t* A; const bf16_t* Bt; int M, N, K; };

struct StaticOrder {
    int nM, nN, nwg, G, c;
    __host__ __device__ void init(int M, int N, int G_, int c_) { nM = M / BM; nN = N / BM; nwg = nM * nN; G = G_; c = c_; }
    __host__ __device__ bool next(int i, Unit& u) const {
        const long L = (long)i * G + c; if (L >= nwg) return false;
        int wgid = (int)L; { const int q = nwg / NXCD, r = nwg % NXCD, xcd = wgid % NXCD, off = wgid / NXCD; wgid = (xcd < r ? xcd * (q + 1) : r * (q + 1) + (xcd - r) * q) + off; }
        const int nig = WGM * nN, gid = wgid / nig, fm = gid * WGM, gsz = (nM - fm) < WGM ? (nM - fm) : WGM;
        u.pm = fm + ((wgid % nig) % gsz); u.pn = (wgid % nig) / gsz; return true;
    }
    __device__ __forceinline__ void a_ready(const Unit&) const {}
    __device__ __forceinline__ void done(const Unit&) const {}
};
__device__ __forceinline__ unsigned cvt_pk_bf16(float lo, float hi) { unsigned r; asm volatile("v_cvt_pk_bf16_f32 %0, %1, %2" : "=v"(r) : "v"(lo), "v"(hi)); return r; }
template <class Epi, class Sched, bool ALIGN_EPI = false, bool SP2 = false>
__device__ __forceinline__ void gemm_phase(PG8_LAS unsigned char* lds, const Gemm g, const Sched& S, const Epi& E) {
    int tid_ = threadIdx.x; asm volatile("" : "+v"(tid_));
    const int tid = tid_, wid = __builtin_amdgcn_readfirstlane(tid >> 6), lane = tid & 63, wr = wid >> 2, wc = wid & 3, fr = lane & 15, fq = lane >> 4;
    const int K = g.K, nt = K / BK;
    unsigned voffA[2], voffB[2];
#pragma unroll
    for (int i = 0; i < 2; ++i) { int R, C; stage_rc(tid * 16 + i * 8192, R, C); const int Rb = Epi::PERM ? ((R & ~31) + perm32(R & 31)) : R;
        voffA[i] = (unsigned)(R * K + C) * 2u; voffB[i] = (unsigned)(Rb * K + C) * 2u; }
    const size_t kstep = (size_t)(BK * 2);
    const size_t hstep = (size_t)HALF * K * 2;
    const size_t tstep = 2 * hstep;
    const unsigned ldsw = (unsigned)wid * 1024u;
    const int aoff = lds_byte(wr * 64 + fr, fq * 8), boff = lds_byte(wc * 32 + fr, fq * 8);
#define PG8_SA(b, h) (((b) * 2 + (h)) * HTB)
#define PG8_SB(b, h) ((4 + (b) * 2 + (h)) * HTB)
#define PG8_STAGE(bufoff, gbase, voff) do { _Pragma("unroll") for (int _i = 0; _i < 2; ++_i) \
        __builtin_amdgcn_global_load_lds((const unsigned*)((const char*)(gbase) + (voff)[_i]), (PG8_LAS unsigned*)(lds + (bufoff) + ldsw + _i * 8192), 16, 0, 0); } while (0)
#define PG8_LDA(dst, b, h) do { _Pragma("unroll") for (int m = 0; m < 4; ++m) _Pragma("unroll") for (int k = 0; k < 2; ++k) dst[m][k] = *(const PG8_LAS bf16x8*)(lds + PG8_SA(b, h) + aoff + m * 2048 + k * 1024); } while (0)
#define PG8_LDB(dst, b, h) do { _Pragma("unroll") for (int n = 0; n < 2; ++n) _Pragma("unroll") for (int k = 0; k < 2; ++k) dst[n][k] = *(const PG8_LAS bf16x8*)(lds + PG8_SB(b, h) + boff + n * 2048 + k * 1024); } while (0)
#define PG8_MMA(ai, bj, At, Bt) do { __builtin_amdgcn_s_setprio(1); _Pragma("unroll") for (int m = 0; m < 4; ++m) _Pragma("unroll") for (int n = 0; n < 2; ++n) _Pragma("unroll") for (int k = 0; k < 2; ++k) \
        acc[ai][bj][m][n] = __builtin_amdgcn_mfma_f32_16x16x32_bf16(Bt[n][k], At[m][k], acc[ai][bj][m][n], 0, 0, 0); __builtin_amdgcn_s_setprio(0); } while (0)
#define PG8_WAIT_V(n) asm volatile("s_waitcnt vmcnt(" #n ")" ::: "memory")
#define PG8_WAIT_L(n) asm volatile("s_waitcnt lgkmcnt(" #n ")" ::: "memory")
#define PG8_BAR __builtin_amdgcn_s_barrier()
#define PG8_SCHED __builtin_amdgcn_sched_barrier(0)
    Unit cur, nxt; int ui = 0;
    if (!S.next(0, cur)) return;
    f32x4 acc[2][2][4][2];
#pragma unroll
    for (int a = 0; a < 2; ++a)
#pragma unroll
        for (int b = 0; b < 2; ++b)
#pragma unroll
            for (int m = 0; m < 4; ++m)
#pragma unroll
                for (int n = 0; n < 2; ++n) acc[a][b][m][n] = (f32x4){0.f, 0.f, 0.f, 0.f};
    bf16x8 At[4][2], B0[2][2], B1[2][2];
    const char* cA = (const char*)g.A + (size_t)cur.pm * tstep; const char* cB = (const char*)g.Bt + (size_t)cur.pn * tstep;
    S.a_ready(cur);
    if constexpr (SP2) {
        PG8_STAGE(PG8_SB(0, 0), cB, voffB); PG8_STAGE(PG8_SB(0, 1), cB + hstep, voffB); PG8_STAGE(PG8_SA(0, 0), cA, voffA); PG8_STAGE(PG8_SA(0, 1), cA + hstep, voffA);
        if (wr == 1) PG8_BAR;
        PG8_WAIT_V(2); PG8_BAR;
        PG8_STAGE(PG8_SB(1, 0), cB + kstep, voffB); PG8_STAGE(PG8_SA(1, 0), cA + kstep, voffA); PG8_STAGE(PG8_SB(1, 1), cB + hstep + kstep, voffB);
        PG8_WAIT_V(6); PG8_BAR;
    } else {
        PG8_STAGE(PG8_SB(0, 0), cB, voffB); PG8_STAGE(PG8_SA(0, 0), cA, voffA); PG8_STAGE(PG8_SB(0, 1), cB + hstep, voffB); PG8_STAGE(PG8_SA(0, 1), cA + hstep, voffA);
        if (wr == 1) PG8_BAR;
        PG8_WAIT_V(4); PG8_BAR;
        PG8_STAGE(PG8_SB(1, 0), cB + kstep, voffB); PG8_STAGE(PG8_SA(1, 0), cA + kstep, voffA); PG8_STAGE(PG8_SB(1, 1), cB + hstep + kstep, voffB);
        PG8_WAIT_V(6); PG8_BAR;
    }
    for (;;) {
        const bool has_next = S.next(ui + 1, nxt);
        const char* nA = has_next ? (const char*)g.A + (size_t)nxt.pm * tstep : cA; const char* nB = has_next ? (const char*)g.Bt + (size_t)nxt.pn * tstep : cB;
        for (int t = 0; t < nt; t += 2) {
            const bool last = (t == nt - 2);
            const char* a1 = cA + (size_t)(t + 1) * kstep;
            const char* a2 = last ? nA : cA + (size_t)(t + 2) * kstep; const char* b2 = last ? nB : cB + (size_t)(t + 2) * kstep;
            const char* a3 = a2 + kstep; const char* b3 = b2 + kstep;
            if (last && has_next) S.a_ready(nxt);
            if constexpr (SP2) {
            PG8_LDB(B0, 0, 0); PG8_LDB(B1, 0, 1); PG8_SCHED; PG8_LDA(At, 0, 0); PG8_STAGE(PG8_SA(1, 1), a1 + hstep, voffA);
            PG8_WAIT_V(8); PG8_WAIT_L(0); PG8_BAR; PG8_MMA(0, 0, At, B0); PG8_MMA(0, 1, At, B1); PG8_BAR; PG8_SCHED;
            PG8_LDA(At, 0, 1); PG8_STAGE(PG8_SB(0, 0), b2, voffB); PG8_STAGE(PG8_SB(0, 1), b2 + hstep, voffB); PG8_STAGE(PG8_SA(0, 0), a2, voffA);
            PG8_WAIT_V(8); PG8_WAIT_L(0); PG8_BAR; PG8_MMA(1, 0, At, B0); PG8_MMA(1, 1, At, B1); PG8_BAR; PG8_SCHED;
            PG8_LDB(B0, 1, 0); PG8_LDB(B1, 1, 1); PG8_SCHED; PG8_LDA(At, 1, 0); PG8_STAGE(PG8_SA(0, 1), a2 + hstep, voffA);
            PG8_WAIT_V(8); PG8_WAIT_L(0); PG8_BAR; PG8_MMA(0, 0, At, B0); PG8_MMA(0, 1, At, B1); PG8_BAR; PG8_SCHED;
            PG8_LDA(At, 1, 1); PG8_STAGE(PG8_SB(1, 0), b3, voffB); PG8_STAGE(PG8_SB(1, 1), b3 + hstep, voffB); PG8_STAGE(PG8_SA(1, 0), a3, voffA);
            PG8_WAIT_V(8); PG8_WAIT_L(0); PG8_BAR; PG8_MMA(1, 0, At, B0); PG8_MMA(1, 1, At, B1); PG8_BAR; PG8_SCHED;
            } else {
            PG8_LDB(B0, 0, 0); PG8_SCHED; PG8_LDA(At, 0, 0); PG8_STAGE(PG8_SA(1, 1), a1 + hstep, voffA);
            PG8_WAIT_L(8); PG8_BAR; PG8_WAIT_L(0); PG8_MMA(0, 0, At, B0); PG8_BAR; PG8_SCHED;
            PG8_LDB(B1, 0, 1); PG8_STAGE(PG8_SB(0, 0), b2, voffB);
            PG8_BAR; PG8_WAIT_L(0); PG8_MMA(0, 1, At, B1); PG8_BAR;
            PG8_LDA(At, 0, 1); PG8_STAGE(PG8_SA(0, 0), a2, voffA);
            PG8_BAR; PG8_WAIT_L(0); PG8_MMA(1, 0, At, B0); PG8_BAR; PG8_SCHED;
            PG8_STAGE(PG8_SB(0, 1), b2 + hstep, voffB);
            PG8_WAIT_V(6); PG8_BAR; PG8_MMA(1, 1, At, B1); PG8_BAR;
            PG8_LDB(B0, 1, 0); PG8_SCHED; PG8_LDA(At, 1, 0); PG8_STAGE(PG8_SA(0, 1), a2 + hstep, voffA);
            PG8_WAIT_L(8); PG8_BAR; PG8_WAIT_L(0); PG8_MMA(0, 0, At, B0); PG8_BAR; PG8_SCHED;
            PG8_LDB(B1, 1, 1); PG8_STAGE(PG8_SB(1, 0), b3, voffB);
            PG8_BAR; PG8_WAIT_L(0); PG8_MMA(0, 1, At, B1); PG8_BAR;
            PG8_LDA(At, 1, 1); PG8_STAGE(PG8_SA(1, 0), a3, voffA);
            PG8_BAR; PG8_WAIT_L(0); PG8_MMA(1, 0, At, B0); PG8_BAR; PG8_SCHED;
            PG8_STAGE(PG8_SB(1, 1), b3 + hstep, voffB);
            PG8_WAIT_V(6); PG8_BAR; PG8_MMA(1, 1, At, B1); PG8_BAR;
            }
        }
        if constexpr (ALIGN_EPI) { if (wr == 0) PG8_BAR; }
        if constexpr (!Epi::AFTER_DRAIN) { E(acc, cur, wr, wc, fr, fq); S.done(cur); }
        if (!has_next) break;
#pragma unroll
        for (int a = 0; a < 2; ++a)
#pragma unroll
            for (int b = 0; b < 2; ++b)
#pragma unroll
                for (int m = 0; m < 4; ++m)
#pragma unroll
                    for (int n = 0; n < 2; ++n) acc[a][b][m][n] = (f32x4){0.f, 0.f, 0.f, 0.f};
        cur = nxt; cA = nA; cB = nB; ++ui;
        if constexpr (ALIGN_EPI) { if (wr == 1) PG8_BAR; }
    }
    PG8_WAIT_V(0);
    if constexpr (!ALIGN_EPI) { if (wr == 0) PG8_BAR; }
    PG8_BAR;
    if constexpr (Epi::AFTER_DRAIN) { E.fused(acc, cur, wr, wc, fr, fq, lds, wid, lane); S.done(cur); }
#undef PG8_SA
#undef PG8_SB
#undef PG8_STAGE
#undef PG8_LDA
#undef PG8_LDB
#undef PG8_MMA
#undef PG8_WAIT_V
#undef PG8_WAIT_L
#undef PG8_BAR
#undef PG8_SCHED
}
}

__device__ __forceinline__ float row_rstd(const float* ssq, int row) {
    const f32x4* pp = (const f32x4*)(ssq + (size_t)row * 16);
    const f32x4 a = (pp[0] + pp[1]) + (pp[2] + pp[3]);
    return rsqrtf(((a[0] + a[1]) + (a[2] + a[3])) * (1.f / DM) + EPSV);
}
template <int ACT> struct EpiNorm {
    static constexpr bool PERM = true, AFTER_DRAIN = false;
    bf16_t* O; int ldc; const float* ssq;
    __device__ __forceinline__ void operator()(const f32x4 (&acc)[2][2][4][2], const pg8::Unit& u, int wr, int wc, int fr, int fq) const {
        const int row0 = u.pm * 256 + wr * 64 + fr, col0 = u.pn * 256 + wc * 32 + 8 * fq;
#pragma unroll
        for (int ai = 0; ai < 2; ++ai)
#pragma unroll
            for (int m = 0; m < 4; ++m) {
                const int row = row0 + ai * 128 + m * 16;
                const float rs = row_rstd(ssq, row);
                bf16_t* rowp = O + (size_t)row * ldc + col0;
#pragma unroll
                for (int bj = 0; bj < 2; ++bj) {
                    f32x4 v0 = acc[ai][bj][m][0] * rs, v1 = acc[ai][bj][m][1] * rs;
                    if (ACT == 1) {
#pragma unroll
                        for (int q = 0; q < 4; ++q) { const float a = fmaxf(v0[q], 0.f), b = fmaxf(v1[q], 0.f); v0[q] = a * a; v1[q] = b * b; }
                    }
                    u32x4 o; o[0] = pg8::cvt_pk_bf16(v0[0], v0[1]); o[1] = pg8::cvt_pk_bf16(v0[2], v0[3]); o[2] = pg8::cvt_pk_bf16(v1[0], v1[1]); o[3] = pg8::cvt_pk_bf16(v1[2], v1[3]);
                    *(u32x4*)(rowp + bj * 128) = o;
                }
            }
    }
};
struct EpiRes {
    static constexpr bool PERM = true, AFTER_DRAIN = false;
    float* xres; bf16_t* xb; float* ssq;
    __device__ __forceinline__ void operator()(const f32x4 (&acc)[2][2][4][2], const pg8::Unit& u, int wr, int wc, int fr, int fq) const {
        const int row0 = u.pm * 256 + wr * 64 + fr, col0 = u.pn * 256 + wc * 32 + 8 * fq;
#pragma unroll
        for (int ai = 0; ai < 2; ++ai)
#pragma unroll
            for (int m = 0; m < 4; ++m) {
                const int row = row0 + ai * 128 + m * 16;
                float sq = 0.f;
#pragma unroll
                for (int bj = 0; bj < 2; ++bj) {
                    float* xp = xres + (size_t)row * DM + col0 + bj * 128;
                    const f32x4 x0 = *(const f32x4*)xp + acc[ai][bj][m][0], x1 = *(const f32x4*)(xp + 4) + acc[ai][bj][m][1];
                    *(f32x4*)xp = x0; *(f32x4*)(xp + 4) = x1;
                    u32x4 o; o[0] = pg8::cvt_pk_bf16(x0[0], x0[1]); o[1] = pg8::cvt_pk_bf16(x0[2], x0[3]); o[2] = pg8::cvt_pk_bf16(x1[0], x1[1]); o[3] = pg8::cvt_pk_bf16(x1[2], x1[3]);
                    *(u32x4*)(xb + (size_t)row * DM + col0 + bj * 128) = o;
                    sq += (x0[0] * x0[0] + x0[1] * x0[1]) + (x0[2] * x0[2] + x0[3] * x0[3]) + (x1[0] * x1[0] + x1[1] * x1[1]) + (x1[2] * x1[2] + x1[3] * x1[3]);
                }
                sq += __shfl_xor(sq, 16); sq += __shfl_xor(sq, 32);
                if (fq == 0) ssq[(size_t)row * 16 + u.pn * 4 + wc] = sq;
            }
    }
};
template <class Epi>
__device__ __forceinline__ void gemm_run(char* lds, const bf16_t* A, const bf16_t* Bt, int N, int K, const Epi& E) {
    pg8::Gemm g; g.A = A; g.Bt = Bt; g.M = NTOK; g.N = N; g.K = K;
    pg8::StaticOrder S; S.init(NTOK, N, gridDim.x, blockIdx.x);
    pg8::gemm_phase<Epi, pg8::StaticOrder, true, true>((PG8_LAS unsigned char*)lds, g, S, E);
}

struct Item { int b, h, c, cs, row0; bool sample; };
__device__ __forceinline__ Item decode_item(int item) {
    Item r;
    if (item < 1024) { r.b = item >> 7; r.h = (item >> 5) & 3; r.c = item & 31; r.cs = 64; r.row0 = r.b * 2048 + r.c * 64; r.sample = false; }
    else { const int s = item - 1024; r.b = s >> 2; r.h = s & 3; r.c = 0; r.cs = 32; r.row0 = NPROMPT + r.b * 32; r.sample = true; }
    return r;
}

__device__ void delta_prep(const Params& p, int l, int item, char* lds) {
    const Item it = decode_item(item);
    const int cs = it.cs, h = it.h, t = tid_opaque(), lane = t & 63, w = t >> 6, fr = lane & 15, fq = lane >> 4;
    float* Ks = (float*)lds;
    float* X = (float*)(lds + 16640);
    float* Am = (float*)(lds + 49664);
    bf16_t* QKm = (bf16_t*)(lds + 66304);
    float* Gs = (float*)(lds + 74752);
    float* Bs = (float*)(lds + 75008);
    const bf16_t* P = (const bf16_t*)(p.ws + OFF_REG + R_P);
    const float* cw = p.conv_w + (size_t)l * 4 * 768;
    const float* hist = p.state_conv + (size_t)(l * 32 + it.b) * 3 * 768;
    bf16_t* Raw = (bf16_t*)(lds + 49664);
    __syncthreads();
    for (int e = t; e < (cs + 3) * 24; e += 256) {
        const int r = e / 24, ci = e - r * 24, which = ci >> 3, d0 = (ci & 7) * 8, tt = r - 3, cwi = which * 256 + h * 64 + d0;
        u32x4 v = (u32x4){0u, 0u, 0u, 0u};
        if (tt >= 0 || (!it.sample && it.c > 0)) v = *(const u32x4*)(P + (size_t)(it.row0 + tt) * PC + C_QC + cwi);
        else if (it.sample) {
            const float4 a = *(const float4*)(hist + (3 + tt) * 768 + cwi), b = *(const float4*)(hist + (3 + tt) * 768 + cwi + 4);
            v[0] = pack2(a.x, a.y); v[1] = pack2(a.z, a.w); v[2] = pack2(b.x, b.y); v[3] = pack2(b.z, b.w);
        }
        *(u32x4*)(Raw + r * 192 + ci * 8) = v;
    }
    __syncthreads();
    for (int e = t; e < cs * 192; e += 256) {
        const int tok = e / 192, ch = e - tok * 192, which = ch >> 6, d = ch & 63, cwi = which * 256 + h * 64 + d;
        float acc = 0.f;
#pragma unroll
        for (int j = 0; j < 4; ++j) acc += bf2f(Raw[(tok + j) * 192 + ch]) * cw[j * 768 + cwi];
        const float cv = siluf(acc);
        if (which == 0) X[tok * 129 + 64 + d] = cv; else if (which == 1) Ks[tok * 65 + d] = cv; else X[tok * 129 + d] = cv;
    }
    __syncthreads();
    for (int tok = w; tok < cs; tok += 4) {
        const float kv = Ks[tok * 65 + lane], qv = X[tok * 129 + 64 + lane];
        const float sk = wave_sum(kv * kv), sq = wave_sum(qv * qv);
        Ks[tok * 65 + lane] = kv * rsqrtf(sk + EPSV);
        X[tok * 129 + 64 + lane] = qv * rsqrtf(sq + EPSV) * 0.125f;
    }
    if (t < cs) {
        const float a = bf2f(P[(size_t)(it.row0 + t) * PC + C_AC + h]), bb = bf2f(P[(size_t)(it.row0 + t) * PC + C_BC + h]);
        const float xs = a + p.dt_bias[l * 4 + h];
        const float sp = fmaxf(xs, 0.f) + __logf(1.f + __expf(-fabsf(xs)));
        Gs[t] = -expf(p.a_log[l * 4 + h]) * sp;
        Bs[t] = 1.f / (1.f + expf(-bb));
    }
    __syncthreads();
    if (w == 0) {
        float v = lane < cs ? Gs[lane] : 0.f;
#pragma unroll
        for (int o = 1; o < 64; o <<= 1) { const float n = __shfl_up(v, o); if (lane >= o) v += n; }
        if (lane < cs) Gs[lane] = v;
    }
    __syncthreads();
    const bool act = (w * 16 < cs);
    f32x4 qreg[4];
    if (act) {
        f32x4 aK[4], aQ[4];
#pragma unroll
        for (int jt = 0; jt < 4; ++jt) {
            aK[jt] = (f32x4){0.f, 0.f, 0.f, 0.f}; aQ[jt] = aK[jt];
            if (jt * 16 < cs) {
                aK[jt] = mm16(Ks + w * 16 * 65, 65, 1, Ks + jt * 16 * 65, 1, 65, 64, aK[jt], lane);
                aQ[jt] = mm16(X + w * 16 * 129 + 64, 129, 1, Ks + jt * 16 * 65, 1, 65, 64, aQ[jt], lane);
            }
        }
#pragma unroll
        for (int nt = 0; nt < 4; ++nt)
#pragma unroll
            for (int r = 0; r < 4; ++r) { const int i = w * 16 + fq * 4 + r; qreg[nt][r] = X[i * 129 + 64 + nt * 16 + fr] * expf(Gs[i]); }
#pragma unroll
        for (int jt = 0; jt < 4; ++jt)
            if (jt * 16 < cs) {
#pragma unroll
                for (int r = 0; r < 4; ++r) {
                    const int i = w * 16 + fq * 4 + r, j = jt * 16 + fr;
                    const float dec = (j <= i) ? expf(Gs[i] - Gs[j]) : 0.f;
                    Am[i * 65 + j] = (j < i) ? Bs[i] * aK[jt][r] * dec : 0.f;
                    QKm[i * 66 + j] = f2bf(aQ[jt][r] * dec);
                }
            }
    }
    __syncthreads();
    for (int e = t; e < cs * 64; e += 256) {
        const int i = e >> 6, d = e & 63;
        const float b = Bs[i];
        X[i * 129 + 64 + d] = b * expf(Gs[i]) * Ks[i * 65 + d];
        X[i * 129 + d] *= b;
    }
    __syncthreads();
    for (int r0 = 0; r0 < cs; r0 += 16) {
        if (r0 > 0) {
#pragma unroll
            for (int q2 = 0; q2 < 2; ++q2) {
                const int ct = w * 2 + q2;
                f32x4 z = (f32x4){0.f, 0.f, 0.f, 0.f};
                const f32x4 c = mm16s(Am + r0 * 65, 65, 1, X + ct * 16, 129, 1, r0, z, lane);
#pragma unroll
                for (int r = 0; r < 4; ++r) X[(r0 + fq * 4 + r) * 129 + ct * 16 + fr] -= c[r];
            }
            __syncthreads();
        }
        if (t < 128) {
            float x[16];
#pragma unroll
            for (int i = 0; i < 16; ++i) x[i] = X[(r0 + i) * 129 + t];
#pragma unroll
            for (int i = 1; i < 16; ++i) {
                const float* ar = Am + (r0 + i) * 65 + r0;
#pragma unroll
                for (int j = 0; j < i; ++j) x[i] -= ar[j] * x[j];
            }
#pragma unroll
            for (int i = 1; i < 16; ++i) X[(r0 + i) * 129 + t] = x[i];
        }
        __syncthreads();
    }
    const float gl = Gs[cs - 1];
    for (int e = t; e < cs * 64; e += 256) { const int i = e >> 6, d = e & 63; Ks[i * 65 + d] *= expf(gl - Gs[i]); }
    __syncthreads();
    float* oM = (float*)(p.ws + OFF_REG + R_DM) + (size_t)item * 4096;
    float* oN = (float*)(p.ws + OFF_REG + R_DN) + (size_t)item * 4096;
    bf16_t* oR = (bf16_t*)(p.ws + OFF_REG + R_DR) + (size_t)item * 4096;
    bf16_t* oO = (bf16_t*)(p.ws + OFF_REG + R_DO0) + (size_t)item * 4096;
    const float egl = expf(gl);
#pragma unroll
    for (int bt = 0; bt < 4; ++bt) {
        f32x4 z = (f32x4){0.f, 0.f, 0.f, 0.f};
        f32x4 cm = mm16(Ks + w * 16, 1, 65, X + 64 + bt * 16, 129, 1, cs, z, lane);
        f32x4 cn = mm16(Ks + w * 16, 1, 65, X + bt * 16, 129, 1, cs, z, lane);
#pragma unroll
        for (int r = 0; r < 4; ++r) {
            const int a = w * 16 + fq * 4 + r, b = bt * 16 + fr;
            oM[a * 64 + b] = ((a == b) ? egl : 0.f) - cm[r];
            oN[a * 64 + b] = cn[r];
        }
    }
    if (act) {
#pragma unroll
        for (int bt = 0; bt < 4; ++bt) {
            f32x4 z = (f32x4){0.f, 0.f, 0.f, 0.f};
            f32x4 cr = mm16(QKm + w * 16 * 66, 66, 1, X + 64 + bt * 16, 129, 1, cs, z, lane);
            f32x4 co = mm16(QKm + w * 16 * 66, 66, 1, X + bt * 16, 129, 1, cs, z, lane);
#pragma unroll
            for (int r = 0; r < 4; ++r) {
                const int i = w * 16 + fq * 4 + r, b = bt * 16 + fr;
                oR[i * 64 + b] = f2bf(qreg[bt][r] - cr[r]);
                oO[i * 64 + b] = f2bf(co[r]);
            }
        }
    }
}

__device__ void gla_prep(const Params& p, int l, int item, char* lds) {
    const Item it = decode_item(item);
    const int cs = it.cs, h = it.h, t = tid_opaque(), lane = t & 63, w = t >> 6, fr = lane & 15, fq = lane >> 4;
    float* Qg = (float*)lds;
    float* Kn = (float*)(lds + 8448);
    float* Kd = (float*)(lds + 16896);
    float* Gs = (float*)(lds + 25344);
    float* Vs = (float*)(lds + 33792);
    float* Att = (float*)(lds + 50432);
    const bf16_t* P = (const bf16_t*)(p.ws + OFF_REG + R_P);
    float* GL = (float*)(lds + 67072);
    float* WG = (float*)(lds + 71424);
    float* Tot = (float*)(lds + 73472);
    __syncthreads();
    for (int e = t; e < cs * 16; e += 256) GL[(e >> 4) * 17 + (e & 15)] = bf2f(P[(size_t)(it.row0 + (e >> 4)) * PC + C_GK + (e & 15)]);
    for (int e = t; e < 512; e += 256) WG[e] = p.gla_w_gk[(size_t)(l * 16 + (e >> 5)) * 128 + h * 32 + (e & 31)];
    __syncthreads();
    for (int e = t; e < cs * 32; e += 256) {
        const int tok = e >> 5, kk = e & 31;
        const bf16_t* pr = P + (size_t)(it.row0 + tok) * PC;
        Qg[tok * 33 + kk] = bf2f(pr[C_QD + h * 32 + kk]);
        Kn[tok * 33 + kk] = bf2f(pr[C_KD + h * 32 + kk]);
        float x = p.gla_b_gk[l * 128 + h * 32 + kk];
#pragma unroll
        for (int r = 0; r < 16; ++r) x += GL[tok * 17 + r] * WG[r * 32 + kk];
        const float ls = fminf(x, 0.f) - __logf(1.f + __expf(-fabsf(x)));
        Gs[tok * 33 + kk] = ls * (1.f / 16.f);
    }
    for (int e = t; e < cs * 64; e += 256) {
        const int tok = e >> 6, d = e & 63;
        Vs[tok * 65 + d] = bf2f(P[(size_t)(it.row0 + tok) * PC + C_VD + h * 64 + d]);
    }
    __syncthreads();
    {
        const int kk = t & 31, part = t >> 5, n = cs >> 3;
        float loc = 0.f;
        for (int i = 0; i < n; ++i) loc += Gs[(part * n + i) * 33 + kk];
        Tot[part * 32 + kk] = loc;
        __syncthreads();
        float base = 0.f;
        for (int pp = 0; pp < part; ++pp) base += Tot[pp * 32 + kk];
        for (int i = 0; i < n; ++i) { base += Gs[(part * n + i) * 33 + kk]; Gs[(part * n + i) * 33 + kk] = base; }
    }
    __syncthreads();
    bf16_t* oQ = (bf16_t*)(p.ws + OFF_REG + R_GQ) + (size_t)item * 2048;
    for (int e = t; e < cs * 32; e += 256) {
        const int tok = e >> 5, kk = e & 31;
        const float G = Gs[tok * 33 + kk], gl = Gs[(cs - 1) * 33 + kk], q = Qg[tok * 33 + kk], k = Kn[tok * 33 + kk];
        const float qg = q * 0.17677669529663687f * expf(G);
        Qg[tok * 33 + kk] = qg; Kn[tok * 33 + kk] = k * expf(-G); Kd[tok * 33 + kk] = k * expf(gl - G);
        oQ[tok * 32 + kk] = f2bf(qg);
    }
    if (t < 32) ((float*)(p.ws + OFF_REG + R_GD))[(size_t)item * 32 + t] = expf(Gs[(cs - 1) * 33 + t]);
    __syncthreads();
    const bool act = (w * 16 < cs);
    if (act) {
#pragma unroll
        for (int jt = 0; jt < 4; ++jt)
            if (jt * 16 < cs) {
                f32x4 z = (f32x4){0.f, 0.f, 0.f, 0.f};
                f32x4 a = mm16(Qg + w * 16 * 33, 33, 1, Kn + jt * 16 * 33, 1, 33, 32, z, lane);
#pragma unroll
                for (int r = 0; r < 4; ++r) { const int i = w * 16 + fq * 4 + r, j = jt * 16 + fr; Att[i * 65 + j] = (j <= i) ? a[r] : 0.f; }
            }
    }
    float* oN = (float*)(p.ws + OFF_REG + R_GN) + (size_t)item * 2048;
#pragma unroll
    for (int q2 = 0; q2 < 2; ++q2) {
        const int tile = w + 4 * q2, at = tile >> 2, vt = tile & 3;
        f32x4 z = (f32x4){0.f, 0.f, 0.f, 0.f};
        f32x4 cn = mm16(Kd + at * 16, 1, 33, Vs + vt * 16, 65, 1, cs, z, lane);
#pragma unroll
        for (int r = 0; r < 4; ++r) oN[(at * 16 + fq * 4 + r) * 64 + vt * 16 + fr] = cn[r];
    }
    __syncthreads();
    if (act) {
        bf16_t* oO = (bf16_t*)(p.ws + OFF_REG + R_GO0) + (size_t)item * 4096;
#pragma unroll
        for (int vt = 0; vt < 4; ++vt) {
            f32x4 z = (f32x4){0.f, 0.f, 0.f, 0.f};
            f32x4 co = mm16(Att + w * 16 * 65, 65, 1, Vs + vt * 16, 65, 1, cs, z, lane);
#pragma unroll
            for (int r = 0; r < 4; ++r) oO[(w * 16 + fq * 4 + r) * 64 + vt * 16 + fr] = f2bf(co[r]);
        }
    }
}

__device__ void delta_scan(const Params& p, int l, int idx, char* lds) {
    const int t = tid_opaque(), lane = t & 63, w = t >> 6, fr = lane & 15, fq = lane >> 4;
    float* Sl = (float*)lds;
    const int bh = idx >> 2, v0 = (idx & 3) * 16, item0 = bh * 32;
    float* outp = p.out + O_DELTAP + ((size_t)l * 32 + bh) * 4096;
    const float* gM = (const float*)(p.ws + OFF_REG + R_DM) + (size_t)item0 * 4096 + (w * 16 + fr) * 64 + fq;
    const float* gN = (const float*)(p.ws + OFF_REG + R_DN) + (size_t)item0 * 4096 + (w * 16 + fq * 4) * 64 + v0 + fr;
    float* gS = (float*)(p.ws + OFF_REG + R_DS) + (size_t)item0 * 4096 + (w * 16 + fq * 4) * 64 + v0 + fr;
    f32x4 sreg = (f32x4){0.f, 0.f, 0.f, 0.f};
    __syncthreads();
#pragma unroll
    for (int r = 0; r < 4; ++r) Sl[(w * 16 + fq * 4 + r) * 17 + fr] = 0.f;
    float aMn[16]; f32x4 accn;
#pragma unroll
    for (int kk = 0; kk < 16; ++kk) aMn[kk] = gM[kk * 4];
#pragma unroll
    for (int r = 0; r < 4; ++r) accn[r] = gN[r * 64];
    __syncthreads();
    for (int c = 0; c < 32; ++c) {
        float aM[16]; f32x4 acc = accn;
#pragma unroll
        for (int kk = 0; kk < 16; ++kk) aM[kk] = aMn[kk];
        const size_t nb = (size_t)(c < 31 ? c + 1 : 31) * 4096;
#pragma unroll
        for (int kk = 0; kk < 16; ++kk) aMn[kk] = gM[nb + kk * 4];
#pragma unroll
        for (int r = 0; r < 4; ++r) { accn[r] = gN[nb + r * 64]; gS[(size_t)c * 4096 + r * 64] = sreg[r]; }
        const float* Sc = Sl + (c & 1) * (64 * 17);
        float* Sn = Sl + ((c + 1) & 1) * (64 * 17);
#pragma unroll
        for (int kk = 0; kk < 16; ++kk) acc = __builtin_amdgcn_mfma_f32_16x16x4f32(aM[kk], Sc[(kk * 4 + fq) * 17 + fr], acc, 0, 0, 0);
        sreg = acc;
#pragma unroll
        for (int r = 0; r < 4; ++r) Sn[(w * 16 + fq * 4 + r) * 17 + fr] = sreg[r];
        __syncthreads();
    }
#pragma unroll
    for (int r = 0; r < 4; ++r) outp[(w * 16 + fq * 4 + r) * 64 + v0 + fr] = sreg[r];
}

__device__ void gla_scan(const Params& p, int l, int idx) {
    const int t = tid_opaque();
    const int bh = idx >> 3, e = (idx & 7) * 256 + t, item0 = bh * 32, a = e >> 6;
    float* outp = p.out + O_GLAP + ((size_t)l * 32 + bh) * 2048;
    const float* gN = (const float*)(p.ws + OFF_REG + R_GN) + (size_t)item0 * 2048 + e;
    const float* gD = (const float*)(p.ws + OFF_REG + R_GD) + (size_t)item0 * 32 + a;
    float* gS = (float*)(p.ws + OFF_REG + R_GS) + (size_t)item0 * 2048 + e;
    float S = 0.f;
#pragma unroll 8
    for (int c = 0; c < 32; ++c) { gS[(size_t)c * 2048] = S; S = gD[c * 32] * S + gN[(size_t)c * 2048]; }
    outp[e] = S;
}

__device__ void attn_item(const Params& p, int l, int item, char* lds) {
    bf16_t* Ks = (bf16_t*)lds;
    bf16_t* Vt = (bf16_t*)(lds + 9216);
    float* bias = (float*)(lds + 18432);
    const bf16_t* P = (const bf16_t*)(p.ws + OFF_REG + R_P);
    bf16_t* mix = (bf16_t*)(p.ws + OFF_REG + R_MIX);
    const int t = tid_opaque(), lane = t & 63, w = t >> 6, fr = lane & 15, fq = lane >> 4;
    int b, h, c = 0, nq, qrow0, nkb, kb0 = 0; bool sample;
    if (item < 1024) { b = item >> 7; c = (item >> 2) & 31; h = item & 3; nq = 64; qrow0 = b * 2048 + c * 64; kb0 = c > 8 ? c - 8 : 0; nkb = c - kb0 + 1; sample = false; }
    else { const int s = item - 1024; b = s >> 2; h = s & 3; nq = 32; qrow0 = NPROMPT + b * 32; nkb = 9; sample = true; }
    __syncthreads();
    for (int i = t; i < 513; i += 256) bias[i] = p.rel_bias[(size_t)(l * 4 + h) * 513 + i];
    const bool act = (w * 16 < nq);
    bf16x8 qf0 = {0, 0, 0, 0, 0, 0, 0, 0}, qf1 = qf0;
    if (act) { const bf16_t* qp = P + (size_t)(qrow0 + w * 16 + fr) * PC + C_QB + h * 64 + fq * 8; qf0 = *(const bf16x8*)qp; qf1 = *(const bf16x8*)(qp + 32); }
    float m = -1e30f, lsum = 0.f;
    f32x4 o[4];
#pragma unroll
    for (int i = 0; i < 4; ++i) o[i] = (f32x4){0.f, 0.f, 0.f, 0.f};
    const int qi = w * 16 + fr;
    const int key = t >> 2, dc = (t & 3) * 16;
    uint4 k0, k1, v0, v1; int nvalid = 64, relbase = 0;
    auto load_kv = [&](int kb) {
        nvalid = 64;
        if (!sample) {
            relbase = (kb0 + kb - c) * 64;
            const bf16_t* kp = P + (size_t)(b * 2048 + (kb0 + kb) * 64 + key) * PC + C_KB + h * 64 + dc;
            k0 = *(const uint4*)kp; k1 = *(const uint4*)(kp + 8); v0 = *(const uint4*)(kp + 256); v1 = *(const uint4*)(kp + 264);
        } else if (kb < 8) {
            relbase = kb * 64 - 512;
            const size_t off = ((((size_t)l * 32 + b) * 4 + h) * 512 + kb * 64 + key) * 64 + dc;
            const float4* kp = (const float4*)(p.cache_k + off); const float4* vp = (const float4*)(p.cache_v + off);
            float4 a = kp[0], bb = kp[1], cc = kp[2], dd = kp[3];
            k0.x = pack2(a.x, a.y); k0.y = pack2(a.z, a.w); k0.z = pack2(bb.x, bb.y); k0.w = pack2(bb.z, bb.w);
            k1.x = pack2(cc.x, cc.y); k1.y = pack2(cc.z, cc.w); k1.z = pack2(dd.x, dd.y); k1.w = pack2(dd.z, dd.w);
            a = vp[0]; bb = vp[1]; cc = vp[2]; dd = vp[3];
            v0.x = pack2(a.x, a.y); v0.y = pack2(a.z, a.w); v0.z = pack2(bb.x, bb.y); v0.w = pack2(bb.z, bb.w);
            v1.x = pack2(cc.x, cc.y); v1.y = pack2(cc.z, cc.w); v1.z = pack2(dd.x, dd.y); v1.w = pack2(dd.z, dd.w);
        } else {
            relbase = 0; nvalid = 32;
            k0 = make_uint4(0, 0, 0, 0); k1 = k0; v0 = k0; v1 = k0;
            if (key < 32) {
                const bf16_t* kp = P + (size_t)(NPROMPT + b * 32 + key) * PC + C_KB + h * 64 + dc;
                k0 = *(const uint4*)kp; k1 = *(const uint4*)(kp + 8); v0 = *(const uint4*)(kp + 256); v1 = *(const uint4*)(kp + 264);
            }
        }
    };
    load_kv(0);
    for (int kb = 0; kb < nkb; ++kb) {
        const int cur_nvalid = nvalid, cur_relbase = relbase;
        __syncthreads();
        *(uint4*)(Ks + key * 72 + dc) = k0; *(uint4*)(Ks + key * 72 + dc + 8) = k1;
        {
            const unsigned vv[8] = {v0.x, v0.y, v0.z, v0.w, v1.x, v1.y, v1.z, v1.w};
#pragma unroll
            for (int j = 0; j < 8; ++j) { Vt[(dc + 2 * j) * 72 + key] = (bf16_t)(vv[j] & 0xffffu); Vt[(dc + 2 * j + 1) * 72 + key] = (bf16_t)(vv[j] >> 16); }
        }
        __syncthreads();
        if (kb + 1 < nkb) load_kv(kb + 1);
        if (act) {
            f32x4 s[4];
#pragma unroll
            for (int tt = 0; tt < 4; ++tt) {
                const bf16_t* kr = Ks + (tt * 16 + fr) * 72 + fq * 8;
                f32x4 z = (f32x4){0.f, 0.f, 0.f, 0.f};
                z = __builtin_amdgcn_mfma_f32_16x16x32_bf16(*(const bf16x8*)kr, qf0, z, 0, 0, 0);
                z = __builtin_amdgcn_mfma_f32_16x16x32_bf16(*(const bf16x8*)(kr + 32), qf1, z, 0, 0, 0);
                s[tt] = z;
            }
            float mb = -1e30f;
#pragma unroll
            for (int tt = 0; tt < 4; ++tt)
#pragma unroll
                for (int r = 0; r < 4; ++r) {
                    const int kj = tt * 16 + fq * 4 + r;
                    int rel = cur_relbase + kj - qi; rel = rel < -256 ? -256 : (rel > 256 ? 256 : rel);
                    float sc = s[tt][r] * 0.125f + bias[rel + 256];
                    sc = (kj < cur_nvalid) ? sc : -1e30f;
                    s[tt][r] = sc; mb = fmaxf(mb, sc);
                }
            mb = fmaxf(mb, __shfl_xor(mb, 16)); mb = fmaxf(mb, __shfl_xor(mb, 32));
            const float mn = fmaxf(m, mb), alpha = __expf(m - mn);
            m = mn;
            float ps = 0.f;
#pragma unroll
            for (int tt = 0; tt < 4; ++tt)
#pragma unroll
                for (int r = 0; r < 4; ++r) { const float pv = __expf(s[tt][r] - mn); s[tt][r] = pv; ps += pv; }
            lsum = lsum * alpha + ps;
#pragma unroll
            for (int dt = 0; dt < 4; ++dt) o[dt] *= alpha;
#pragma unroll
            for (int u = 0; u < 2; ++u) {
                union { bf16x8 v; unsigned q[4]; } pf;
                pf.q[0] = pack2(s[2 * u][0], s[2 * u][1]); pf.q[1] = pack2(s[2 * u][2], s[2 * u][3]);
                pf.q[2] = pack2(s[2 * u + 1][0], s[2 * u + 1][1]); pf.q[3] = pack2(s[2 * u + 1][2], s[2 * u + 1][3]);
#pragma unroll
                for (int dt = 0; dt < 4; ++dt) {
                    const bf16_t* vr = Vt + (dt * 16 + fr) * 72 + u * 32 + fq * 4;
                    union { bf16x8 v; uint2 q[2]; } vf;
                    vf.q[0] = *(const uint2*)vr; vf.q[1] = *(const uint2*)(vr + 16);
                    o[dt] = __builtin_amdgcn_mfma_f32_16x16x32_bf16(vf.v, pf.v, o[dt], 0, 0, 0);
                }
            }
        }
    }
    if (act) {
        lsum += __shfl_xor(lsum, 16); lsum += __shfl_xor(lsum, 32);
        const float inv = 1.f / lsum;
        bf16_t* op = mix + (size_t)(qrow0 + qi) * DM + 256 + h * 64 + fq * 4;
#pragma unroll
        for (int dt = 0; dt < 4; ++dt) { uint2 ov; ov.x = pack2(o[dt][0] * inv, o[dt][1] * inv); ov.y = pack2(o[dt][2] * inv, o[dt][3] * inv); *(uint2*)(op + dt * 16) = ov; }
    }
}

__device__ void delta_out(const Params& p, int l, int item, char* lds) {
    const Item it = decode_item(item);
    const int cs = it.cs, h = it.h, t = tid_opaque(), lane = t & 63, w = t >> 6, fr = lane & 15, fq = lane >> 4;
    bf16_t* Rl = (bf16_t*)lds;
    float* Sl = (float*)(lds + 8448);
    const bf16_t* gR = (const bf16_t*)(p.ws + OFF_REG + R_DR) + (size_t)item * 4096;
    const bf16_t* gO = (const bf16_t*)(p.ws + OFF_REG + R_DO0) + (size_t)item * 4096;
    const float* gS = (const float*)(p.ws + OFF_REG + R_DS) + (size_t)item * 4096;
    const bf16_t* P = (const bf16_t*)(p.ws + OFF_REG + R_P);
    bf16_t* mix = (bf16_t*)(p.ws + OFF_REG + R_MIX);
    __syncthreads();
    for (int e = t; e < cs * 64; e += 256) Rl[(e >> 6) * 66 + (e & 63)] = gR[e];
    const float* sS = it.sample ? p.state_delta + ((size_t)l * 128 + it.b * 4 + h) * 4096 : gS;
    for (int e = t; e < 4096; e += 256) Sl[(e >> 6) * 65 + (e & 63)] = sS[e];
    __syncthreads();
    if (it.sample) {
        const float* gM = (const float*)(p.ws + OFF_REG + R_DM) + (size_t)item * 4096;
        const float* gN = (const float*)(p.ws + OFF_REG + R_DN) + (size_t)item * 4096;
        float* so = p.out + O_DELTAS + ((size_t)l * 128 + it.b * 4 + h) * 4096;
#pragma unroll
        for (int vt = 0; vt < 4; ++vt) {
            f32x4 a;
#pragma unroll
            for (int r = 0; r < 4; ++r) a[r] = gN[(w * 16 + fq * 4 + r) * 64 + vt * 16 + fr];
            a = mm16(gM + w * 16 * 64, 64, 1, Sl + vt * 16, 65, 1, 64, a, lane);
#pragma unroll
            for (int r = 0; r < 4; ++r) so[(w * 16 + fq * 4 + r) * 64 + vt * 16 + fr] = a[r];
        }
    }
    if (w * 16 < cs) {
        f32x4 acc[4]; float ss[4] = {0.f, 0.f, 0.f, 0.f};
#pragma unroll
        for (int vt = 0; vt < 4; ++vt) {
#pragma unroll
            for (int r = 0; r < 4; ++r) acc[vt][r] = bf2f(gO[(w * 16 + fq * 4 + r) * 64 + vt * 16 + fr]);
            acc[vt] = mm16(Rl + w * 16 * 66, 66, 1, Sl + vt * 16, 65, 1, 64, acc[vt], lane);
#pragma unroll
            for (int r = 0; r < 4; ++r) ss[r] += acc[vt][r] * acc[vt][r];
        }
#pragma unroll
        for (int r = 0; r < 4; ++r) {
            float s = ss[r];
            s += __shfl_xor(s, 1); s += __shfl_xor(s, 2); s += __shfl_xor(s, 4); s += __shfl_xor(s, 8);
            const float rs = rsqrtf(s * (1.f / 64.f) + EPSV);
            const int row = it.row0 + w * 16 + fq * 4 + r;
#pragma unroll
            for (int vt = 0; vt < 4; ++vt) {
                const int v = vt * 16 + fr;
                const float z = bf2f(P[(size_t)row * PC + C_ZC + h * 64 + v]);
                mix[(size_t)row * DM + 512 + h * 64 + v] = f2bf(acc[vt][r] * rs * p.delta_norm_g[l * 64 + v] * siluf(z));
            }
        }
    }
}
__device__ void gla_out(const Params& p, int l, int item, char* lds) {
    const Item it = decode_item(item);
    const int cs = it.cs, h = it.h, t = tid_opaque(), lane = t & 63, w = t >> 6, fr = lane & 15, fq = lane >> 4;
    bf16_t* Ql = (bf16_t*)lds;
    float* Sl = (float*)(lds + 4352);
    const bf16_t* gQ = (const bf16_t*)(p.ws + OFF_REG + R_GQ) + (size_t)item * 2048;
    const bf16_t* gO = (const bf16_t*)(p.ws + OFF_REG + R_GO0) + (size_t)item * 4096;
    const float* gS = (const float*)(p.ws + OFF_REG + R_GS) + (size_t)item * 2048;
    const bf16_t* P = (const bf16_t*)(p.ws + OFF_REG + R_P);
    bf16_t* mix = (bf16_t*)(p.ws + OFF_REG + R_MIX);
    __syncthreads();
    for (int e = t; e < cs * 32; e += 256) Ql[(e >> 5) * 34 + (e & 31)] = gQ[e];
    const float* sS = it.sample ? p.state_gla + ((size_t)l * 128 + it.b * 4 + h) * 2048 : gS;
    for (int e = t; e < 2048; e += 256) Sl[(e >> 6) * 65 + (e & 63)] = sS[e];
    if (it.sample) {
        const float* gN = (const float*)(p.ws + OFF_REG + R_GN) + (size_t)item * 2048;
        const float* gD = (const float*)(p.ws + OFF_REG + R_GD) + (size_t)item * 32;
        float* so = p.out + O_GLAS + ((size_t)l * 128 + it.b * 4 + h) * 2048;
        for (int e = t; e < 2048; e += 256) so[e] = gD[e >> 6] * sS[e] + gN[e];
    }
    __syncthreads();
    if (w * 16 < cs) {
        f32x4 acc[4]; float ss[4] = {0.f, 0.f, 0.f, 0.f};
#pragma unroll
        for (int vt = 0; vt < 4; ++vt) {
#pragma unroll
            for (int r = 0; r < 4; ++r) acc[vt][r] = bf2f(gO[(w * 16 + fq * 4 + r) * 64 + vt * 16 + fr]);
            acc[vt] = mm16(Ql + w * 16 * 34, 34, 1, Sl + vt * 16, 65, 1, 32, acc[vt], lane);
#pragma unroll
            for (int r = 0; r < 4; ++r) ss[r] += acc[vt][r] * acc[vt][r];
        }
#pragma unroll
        for (int r = 0; r < 4; ++r) {
            float s = ss[r];
            s += __shfl_xor(s, 1); s += __shfl_xor(s, 2); s += __shfl_xor(s, 4); s += __shfl_xor(s, 8);
            const float rs = rsqrtf(s * (1.f / 64.f) + EPSV);
            const int row = it.row0 + w * 16 + fq * 4 + r;
#pragma unroll
            for (int vt = 0; vt < 4; ++vt) {
                const int v = vt * 16 + fr;
                const float z = bf2f(P[(size_t)row * PC + C_GD + h * 64 + v]);
                mix[(size_t)row * DM + 768 + h * 64 + v] = f2bf(acc[vt][r] * rs * p.gla_norm_g[l * 64 + v] * siluf(z));
            }
        }
    }
}

__device__ void pool_item(const Params& p, int l, int tile, char* lds) {
    const int t = tid_opaque(), lane = t & 63, w = t >> 6, fr = lane & 15, fq = lane >> 4;
    float* U = (float*)lds;
    float* Pl = (float*)lds;
    const bf16_t* P = (const bf16_t*)(p.ws + OFF_REG + R_P);
    bf16_t* mix = (bf16_t*)(p.ws + OFF_REG + R_MIX);
    int b, t0, row0; bool sample;
    if (tile < 512) { b = tile >> 6; t0 = (tile & 63) * 32; row0 = b * 2048 + t0; sample = false; }
    else { b = tile - 512; t0 = 0; row0 = NPROMPT + b * 32; sample = true; }
    __syncthreads();
    for (int e = t; e < 47 * 64; e += 256) {
        const int r = e >> 6, ch = (e & 63) * 4, tt = r - 15;
        float4 v = make_float4(0.f, 0.f, 0.f, 0.f);
        if (t0 + tt >= 0) { const uint2 q = *(const uint2*)(P + (size_t)(row0 + tt) * PC + C_UA + ch);
            v.x = __uint_as_float(q.x << 16); v.y = __uint_as_float(q.x & 0xffff0000u); v.z = __uint_as_float(q.y << 16); v.w = __uint_as_float(q.y & 0xffff0000u); }
        else if (sample) v = *(const float4*)(p.cache_pool + ((size_t)(l * 32 + b) * 15 + (15 + tt)) * 256 + ch);
        *(float4*)(U + r * 256 + ch) = v;
    }
    __syncthreads();
    float pv[32];
    {
        const int ch = t, g = ch >> 6, win = 2 << g;
#pragma unroll
        for (int tt = 0; tt < 32; ++tt) {
            float s = 0.f;
            for (int j = 0; j < win; ++j) s += U[(15 + tt - j) * 256 + ch];
            const int pos1 = t0 + tt + 1;
            const float cnt = (sample || pos1 > win) ? (float)win : (float)pos1;
            pv[tt] = s / cnt - U[(15 + tt) * 256 + ch];
        }
    }
    __syncthreads();
#pragma unroll
    for (int tt = 0; tt < 32; ++tt) Pl[(t >> 6) * (32 * 68) + tt * 68 + (t & 63)] = pv[tt];
    __syncthreads();
    const float* Wg = p.pool_w + (size_t)(l * 4 + w) * 4096;
#pragma unroll
    for (int mt = 0; mt < 2; ++mt)
#pragma unroll
        for (int ct = 0; ct < 4; ++ct) {
            f32x4 z = (f32x4){0.f, 0.f, 0.f, 0.f};
            const f32x4 y = mm16(Pl + w * (32 * 68) + mt * 16 * 68, 68, 1, Wg + ct * 16, 64, 1, 64, z, lane);
            const int d = w * 64 + ct * 16 + fr;
            const float sc = p.pool_scale[l * 256 + d];
#pragma unroll
            for (int r = 0; r < 4; ++r) mix[(size_t)(row0 + mt * 16 + fq * 4 + r) * DM + d] = f2bf(y[r] * sc);
        }
}

__device__ void copy_outs(const Params& p, int l) {
    const bf16_t* P = (const bf16_t*)(p.ws + OFF_REG + R_P);
    int t512 = threadIdx.x; asm volatile("" : "+v"(t512));
    const size_t gt = (size_t)blockIdx.x * 512 + t512, gs = (size_t)gridDim.x * 512;
    for (size_t e = gt; e < 2 * 1048576; e += gs) {
        const int kv = (int)(e >> 20), r = (int)(e & 1048575), d = r & 63, j = (r >> 6) & 511, h = (r >> 15) & 3, b = r >> 17;
        p.out[(kv ? O_VP : O_KP) + (size_t)l * 1048576 + r] = bf2f(P[(size_t)(b * 2048 + 1536 + j) * PC + (kv ? C_VB : C_KB) + h * 64 + d]);
    }
    for (size_t e = gt; e < 2 * 262144; e += gs) {
        const int kv = (int)(e >> 18), r = (int)(e & 262143), d = r & 63, j = (r >> 6) & 31, h = (r >> 11) & 3, b = r >> 13;
        p.out[(kv ? O_VS : O_KS) + (size_t)l * 262144 + r] = bf2f(P[(size_t)(NPROMPT + b * 32 + j) * PC + (kv ? C_VB : C_KB) + h * 64 + d]);
    }
    for (size_t e = gt; e < 40 * 3840; e += gs) {
        const int bb = (int)(e / 3840), r = (int)(e % 3840), rr = r >> 8, ch = r & 255;
        if (bb < 8) p.out[O_POOLP + (size_t)l * 30720 + e] = bf2f(P[(size_t)(bb * 2048 + 2033 + rr) * PC + C_UA + ch]);
        else p.out[O_POOLS + (size_t)l * 122880 + (e - 30720)] = bf2f(P[(size_t)(NPROMPT + (bb - 8) * 32 + 17 + rr) * PC + C_UA + ch]);
    }
    for (size_t e = gt; e < 40 * 2304; e += gs) {
        const int bb = (int)(e / 2304), r = (int)(e % 2304), rr = r / 768, ch = r % 768;
        if (bb < 8) p.out[O_CONVP + (size_t)l * 18432 + e] = bf2f(P[(size_t)(bb * 2048 + 2045 + rr) * PC + C_QC + ch]);
        else p.out[O_CONVS + (size_t)l * 73728 + (e - 18432)] = bf2f(P[(size_t)(NPROMPT + (bb - 8) * 32 + 29 + rr) * PC + C_QC + ch]);
    }
}

__device__ void final_rows(const Params& p, int it) {
    const int w = tid_opaque() >> 6, lane = tid_opaque() & 63, row = it * 4 + w;
    const float* xres = (const float*)(p.ws + OFF_XRES) + (size_t)row * DM;
    const f32x4* pp = (const f32x4*)((const float*)(p.ws + OFF_SSQ) + (size_t)row * 16);
    const f32x4 pa = (pp[0] + pp[1]) + (pp[2] + pp[3]);
    const float rs = rsqrtf(((pa[0] + pa[1]) + (pa[2] + pa[3])) * (1.f / DM) + EPSV);
    float* y = p.out + (size_t)row * DM;
#pragma unroll
    for (int i = 0; i < 4; ++i) {
        const int c = lane * 4 + 256 * i;
        float4 v = *(const float4*)(xres + c); const float4 g = *(const float4*)(p.final_norm_g + c);
        v.x *= rs * g.x; v.y *= rs * g.y; v.z *= rs * g.z; v.w *= rs * g.w;
        *(float4*)(y + c) = v;
    }
}

#define ITEMS(total) for (int k_ = B; 2 * k_ < (total); k_ += G)
__device__ void run_phase(const Params& pin, int ph, char* lds0) {
    Params p = pin;
#define LAUNDER(f) asm volatile("" : "+s"(p.f))
    LAUNDER(x_prompt); LAUNDER(x_sample); LAUNDER(cache_pool); LAUNDER(cache_k); LAUNDER(cache_v); LAUNDER(state_conv); LAUNDER(state_delta); LAUNDER(state_gla);
    LAUNDER(attn_norm_g); LAUNDER(w_in); LAUNDER(pool_w); LAUNDER(pool_scale); LAUNDER(rel_bias); LAUNDER(conv_w); LAUNDER(a_log); LAUNDER(dt_bias); LAUNDER(delta_norm_g);
    LAUNDER(gla_w_gk); LAUNDER(gla_b_gk); LAUNDER(gla_norm_g); LAUNDER(w_out); LAUNDER(mlp_norm_g); LAUNDER(w_up); LAUNDER(w_down); LAUNDER(final_norm_g);
    LAUNDER(out); LAUNDER(ws);
#undef LAUNDER
    int thr_ = threadIdx.x; asm volatile("" : "+v"(thr_));
    const int G = gridDim.x, B = blockIdx.x, half = thr_ >> 8;
    char* lds = lds0 + half * HALF_LDS;
    if (ph == 0) {
        ITEMS(CV_TOTAL + NTOK / 4) { const int it = 2 * k_ + half;
            if (it < CV_TOTAL) convert_layer_item(p, 0, it, lds); else prologue_rows(p, it - CV_TOTAL);
        }
        return;
    }
    if (ph == 1 + 7 * DEPTH) { ITEMS(NTOK / 4) { final_rows(p, 2 * k_ + half); } return; }
    const int l = (ph - 1) / 7, sp = (ph - 1) % 7;
    const bf16_t* wb = (const bf16_t*)(p.ws + ((l & 1) ? OFF_WB1 : OFF_WB0));
    float* ssq = (float*)(p.ws + OFF_SSQ);
    bf16_t* xb = (bf16_t*)(p.ws + OFF_XB);
    float* xres = (float*)(p.ws + OFF_XRES);
    if (sp == 0) {
        EpiNorm<0> e; e.O = (bf16_t*)(p.ws + OFF_REG + R_P); e.ldc = PC; e.ssq = ssq;
        gemm_run(lds0, xb, wb + WB_IN, PC, DM, e);
    } else if (sp == 1) {
        ITEMS(2 * NITEM) { const int it = 2 * k_ + half; if (it < NITEM) delta_prep(p, l, it, lds); else gla_prep(p, l, it - NITEM, lds); }
    } else if (sp == 2) {
        ITEMS(128 + 256 + NITEM) {
            int i = 2 * k_ + half;
            if (i < 128) delta_scan(p, l, i, lds);
            else if ((i -= 128) < 256) gla_scan(p, l, i);
            else attn_item(p, l, i - 256, lds);
        }
    } else if (sp == 3) {
        const int ncv = (l + 1 < DEPTH) ? CV_TOTAL : 0;
        ITEMS(2 * NITEM + 544 + ncv) {
            int i = 2 * k_ + half;
            if (i < NITEM) delta_out(p, l, i, lds);
            else if ((i -= NITEM) < NITEM) gla_out(p, l, i, lds);
            else if ((i -= NITEM) < 544) pool_item(p, l, i, lds);
            else convert_layer_item(p, l + 1, i - 544, lds);
        }
        copy_outs(p, l);
    } else if (sp == 4) {
        EpiRes e; e.xres = xres; e.xb = xb; e.ssq = ssq;
        gemm_run(lds0, (const bf16_t*)(p.ws + OFF_REG + R_MIX), wb + WB_OUT, DM, DM, e);
    } else if (sp == 5) {
        EpiNorm<1> e; e.O = (bf16_t*)(p.ws + OFF_REG); e.ldc = DFF; e.ssq = ssq;
        gemm_run(lds0, xb, wb + WB_UP, DFF, DM, e);
    } else {
        EpiRes e; e.xres = xres; e.xb = xb; e.ssq = ssq;
        gemm_run(lds0, (const bf16_t*)(p.ws + OFF_REG), wb + WB_DN, DM, DFF, e);
    }
}
#define XB_TMO      128
#define XB_XCNT(j)  (256  + 64 * (j))
#define XB_XSUB(j)  (1280 + 64 * (j))
#define XB_XGEN(j)  (2304 + 64 * (j))
#define XB_TOP      3328
#define XB_TOPGEN   3392
#define XCD_BAR_WORDS 3456
#define XB_SPIN_CAP (1u << 22)
#define LAS __attribute__((address_space(3)))
__device__ __forceinline__ unsigned xb_ld(unsigned* p)              { return __hip_atomic_load(p, __ATOMIC_RELAXED, __HIP_MEMORY_SCOPE_AGENT); }
__device__ __forceinline__ unsigned xb_add(unsigned* p, unsigned v) { return __hip_atomic_fetch_add(p, v, __ATOMIC_RELAXED, __HIP_MEMORY_SCOPE_AGENT); }
__device__ __forceinline__ unsigned xb_xcc_id() { return (unsigned)__builtin_amdgcn_s_getreg((3 << 11) | 20) & 0xFu; }
#define XB_SPIN(cond, bar) do { unsigned _sp = 0; while (cond) { __builtin_amdgcn_s_sleep(1); \
    if ((++_sp & 255u) == 0u) { if (xb_ld(&(bar)[XB_TMO])) break; if (_sp > XB_SPIN_CAP) { atomicAdd(&(bar)[XB_TMO], 1u); break; } } } } while (0)
struct XcdBarrier { unsigned* bar; unsigned x; volatile LAS unsigned* st; };
__device__ __forceinline__ XcdBarrier xcd_barrier_post(unsigned* bar, volatile LAS unsigned* st) {
    XcdBarrier b; b.bar = bar; b.x = xb_xcc_id(); b.st = st;
    if (threadIdx.x == 0) (void)xb_add(&bar[XB_XCNT(b.x)], 1u);
    return b;
}
__device__ __forceinline__ void xcd_barrier_complete(unsigned* bar, unsigned x, unsigned& nloc, unsigned& nx) {
    const unsigned G = gridDim.x * gridDim.y * gridDim.z;
    unsigned sum, cnt, mine, sp = 0u;
    for (;;) {
        sum = 0u; cnt = 0u; mine = 0u;
#pragma unroll
        for (unsigned j = 0; j < 16; ++j) { const unsigned c = xb_ld(&bar[XB_XCNT(j)]); sum += c; cnt += (c > 0u) ? 1u : 0u; mine = (j == x) ? c : mine; }
        if (sum == G) break;
        __builtin_amdgcn_s_sleep(1);
        if ((++sp & 255u) == 0u) { if (xb_ld(&bar[XB_TMO])) break; if (sp > XB_SPIN_CAP) { atomicAdd(&bar[XB_TMO], 1u); break; } }
    }
    nloc = mine > 0u ? mine : 1u; nx = cnt > 0u ? cnt : 1u;
}
__device__ __forceinline__ void xcd_barrier(const XcdBarrier& b) {
    asm volatile("s_waitcnt vmcnt(0)" ::: "memory");
    __syncthreads();
    if (threadIdx.x == 0) {
        unsigned* bar = b.bar;
        __builtin_amdgcn_s_waitcnt(0);
        unsigned nloc = b.st[0], nx = b.st[1];
        if (nloc == 0u) { xcd_barrier_complete(bar, b.x, nloc, nx); b.st[0] = nloc; b.st[1] = nx; }
        const unsigned old = xb_add(&bar[XB_XSUB(b.x)], 1u);
        const unsigned gen = old / nloc;
        if (old + 1u == (gen + 1u) * nloc) {
            __builtin_amdgcn_fence(__ATOMIC_RELEASE, "agent");
            asm volatile("s_waitcnt vmcnt(0)" ::: "memory");
            const unsigned og = xb_add(&bar[XB_TOP], 1u);
            const unsigned tg = og / nx;
            if (og + 1u == (tg + 1u) * nx) xb_add(&bar[XB_TOPGEN], 1u);
            else XB_SPIN(xb_ld(&bar[XB_TOPGEN]) == tg, bar);
            __builtin_amdgcn_fence(__ATOMIC_ACQUIRE, "agent");
            xb_add(&bar[XB_XGEN(b.x)], 1u);
            asm volatile("s_waitcnt vmcnt(0)" ::: "memory");
        } else {
            XB_SPIN(xb_ld(&bar[XB_XGEN(b.x)]) == gen, bar);
            __builtin_amdgcn_fence(__ATOMIC_ACQUIRE, "agent");
            asm volatile("s_waitcnt vmcnt(0)" ::: "memory");
        }
    }
    __syncthreads();
}

constexpr int NPHASE = 2 + 7 * DEPTH;
constexpr unsigned PROBE_REP = 0x1111111u;

__global__ void __launch_bounds__(512, 2) mega(Params p) {
    extern __shared__ __attribute__((aligned(16))) char lds[];
    volatile LAS unsigned* st = (volatile LAS unsigned*)(lds + LDS_BYTES - 16);
    if (threadIdx.x == 0) { st[0] = 0u; st[1] = 0u; }
    __syncthreads();
    XcdBarrier xb = xcd_barrier_post(p.bar, st);
    for (int ph = p.ph_begin; ph < p.ph_end; ++ph) {
        const int sp_ = (ph >= 1 && ph <= 7 * DEPTH) ? (ph - 1) % 7 : -1;
        const int reps = sp_ < 0 ? 1 : ((PROBE_REP >> (4 * sp_)) & 15);
        for (int r = 0; r < reps; ++r) { run_phase(p, ph, lds); if (r + 1 < reps) xcd_barrier(xb); }
        if (ph + 1 < p.ph_end) { if (p.use_cg) cg::this_grid().sync(); else xcd_barrier(xb); }
    }
}

extern "C" void kernel_launch(void* const* d_in, const int* in_sizes, int n_in, void* d_out, int out_size, void* d_ws, size_t ws_size, hipStream_t stream) {
    static int grid_blocks = 0;
    if (!grid_blocks) {
        int dev = 0, cus = 0, per_cu = 0;
        hipGetDevice(&dev);
        hipDeviceGetAttribute(&cus, hipDeviceAttributeMultiprocessorCount, dev);
        hipFuncSetAttribute((const void*)mega, hipFuncAttributeMaxDynamicSharedMemorySize, LDS_BYTES);
        hipOccupancyMaxActiveBlocksPerMultiprocessor(&per_cu, mega, 512, LDS_BYTES);
        if (per_cu < 1) per_cu = 1;
        grid_blocks = cus * per_cu;
    }
    if (ws_size < WS_NEED) { fprintf(stderr, "workspace too small: %zu < %zu\n", ws_size, (size_t)WS_NEED); return; }
    Params p{};
    const float** f = (const float**)&p;
    for (int i = 0; i < 25; ++i) f[i] = (const float*)d_in[i];
    p.out = (float*)d_out; p.ws = (char*)d_ws; p.bar = (unsigned*)((char*)d_ws + OFF_BAR); p.use_cg = 0; p.pad0 = 0;
    hipMemsetAsync(p.bar, 0, XCD_BAR_WORDS * 4, stream);
#if ONE_LAUNCH
    p.ph_begin = 0; p.ph_end = NPHASE;
    void* args[] = {&p};
    hipError_t e = hipLaunchCooperativeKernel((void*)mega, dim3(grid_blocks), dim3(512), args, LDS_BYTES, stream);
    if (e != hipSuccess) fprintf(stderr, "cooperative launch failed: %s (grid %d)\n", hipGetErrorString(e), grid_blocks);
#else
    for (int ph = 0; ph < NPHASE; ++ph) {
        p.ph_begin = ph; p.ph_end = ph + 1;
        hipLaunchKernelGGL(mega, dim3(grid_blocks), dim3(512), LDS_BYTES, stream, p);
    }
#endif
}
```
